# Optimizing an MI355X kernel written in HIP

```python
import jax, jax.numpy as jnp
from jax import lax
import numpy as np

D_MODEL = 1024
BATCH = 4
SEQ = 8192
DEPTH = 1

HEAD_DIM = 64
ATTN_WIDTH = D_MODEL // 2
N_ATTN_HEADS = ATTN_WIDTH // HEAD_DIM
CONV_WIDTH = D_MODEL - ATTN_WIDTH
IN_PROJ_WIDTH = 3 * ATTN_WIDTH + 2 * CONV_WIDTH
DILATED_BRANCHES = ((128, 1), (512, 4), (2048, 16))
ATTN_BLOCK = 128
ROPE_THETA = 500000.0
ROPE_DIM = HEAD_DIM // 4
CONV_KERNEL = 31
N_EXPERTS = 256
TOP_K = 8
N_GROUPS = 8
TOPK_GROUPS = 4
EXPERT_DIM = D_MODEL // 4
SHARED_DIM = D_MODEL // 4
ROUTED_SCALE = 2.5
MOE_BLOCK = 128
NORM_EPS = 1e-6
NEG_INF = -1e30

kernel_name = "hymba_dilated_attn_conformer_conv_moe_adaln"


def rms_norm(x, g):
    xf = x.astype(jnp.float32)
    y = xf * lax.rsqrt(jnp.mean(xf * xf, axis=-1, keepdims=True) + NORM_EPS)
    return (y * g.astype(jnp.float32)).astype(x.dtype)


def layer_norm(x, g, b):
    xf = x.astype(jnp.float32)
    mu = jnp.mean(xf, axis=-1, keepdims=True)
    var = jnp.mean(jnp.square(xf - mu), axis=-1, keepdims=True)
    y = (xf - mu) * lax.rsqrt(var + NORM_EPS)
    return (y * g.astype(jnp.float32) + b.astype(jnp.float32)).astype(x.dtype)


def partial_rotary(t, positions):
    half = ROPE_DIM // 2
    inv_freq = ROPE_THETA ** (-(jnp.arange(half, dtype=jnp.float32) * 2.0) / ROPE_DIM)
    ang = positions.astype(jnp.float32)[..., None] * inv_freq
    cos = jnp.cos(ang)[:, :, None, :]
    sin = jnp.sin(ang)[:, :, None, :]
    t1 = t[..., :half]
    t2 = t[..., half:ROPE_DIM]
    return jnp.concatenate([t1 * cos - t2 * sin, t2 * cos + t1 * sin, t[..., ROPE_DIM:]], axis=-1)


def dilated_window_attention(q, k, v, window, dilation):
    n_back = window // dilation
    bsz, seq, nh, hd = q.shape
    chunk = dilation * ATTN_BLOCK
    lp = -(-seq // chunk) * chunk
    nb = lp // chunk
    pad = ((0, 0), (0, lp - seq), (0, 0), (0, 0))

    def blocks(t):
        return jnp.pad(t, pad).reshape(bsz, nb, ATTN_BLOCK, dilation, nh, hd)

    def with_prev(t):
        prev = jnp.pad(t[:, :-1], ((0, 0), (1, 0), (0, 0), (0, 0), (0, 0), (0, 0)))
        return jnp.concatenate([prev, t], axis=2)

    qb = blocks(q)
    kc = with_prev(blocks(k))
    vc = with_prev(blocks(v))
    s = jnp.einsum("bnqrhd,bnkrhd->bnrhqk", qb, kc) * (hd ** -0.5)
    qi = jnp.arange(ATTN_BLOCK)[:, None]
    kj = jnp.arange(2 * ATTN_BLOCK)[None, :]
    dist = ATTN_BLOCK + qi - kj
    band = (dist >= 0) & (dist <= n_back)
    first = (jnp.arange(nb) == 0)[:, None, None]
    valid = band[None] & ~(first & (kj < ATTN_BLOCK)[None])
    s = jnp.where(valid[None, :, None, None], s, NEG_INF)
    lse = jax.nn.logsumexp(s, axis=-1)
    p = jnp.exp(s - lse[..., None])
    o = jnp.einsum("bnrhqk,bnkrhd->bnqrhd", p, vc).reshape(bsz, lp, nh, hd)[:, :seq]
    lse = lse.transpose(0, 1, 4, 2, 3).reshape(bsz, lp, nh)[:, :seq]
    return o, lse


def conformer_conv(u, g, w_dw, b_dw, ln_g, ln_b, w_pw2, b_pw2):
    a = u * jax.nn.sigmoid(g)
    y = lax.conv_general_dilated(
        a, w_dw[:, None, :].astype(a.dtype), window_strides=(1,),
        padding=[(CONV_KERNEL - 1, 0)],
        dimension_numbers=("NWC", "WIO", "NWC"),
        feature_group_count=a.shape[-1]) + b_dw
    y = jax.nn.silu(layer_norm(y, ln_g, ln_b))
    return y @ w_pw2 + b_pw2


def moe_ffn(h, w_router, b_router, w_g, w_u, w_d, ws_g, ws_u, ws_d):
    T, D = h.shape
    scores = jax.nn.sigmoid(h.astype(jnp.float32) @ w_router.astype(jnp.float32))
    biased = scores + b_router.astype(jnp.float32)
    grp = biased.reshape(T, N_GROUPS, N_EXPERTS // N_GROUPS)
    grp_score = lax.top_k(grp, 2)[0].sum(-1)
    _, top_groups = lax.top_k(grp_score, TOPK_GROUPS)
    grp_mask = jax.nn.one_hot(top_groups, N_GROUPS, dtype=jnp.float32).sum(1) > 0
    exp_mask = jnp.repeat(grp_mask, N_EXPERTS // N_GROUPS, axis=1)
    _, idx = lax.top_k(jnp.where(exp_mask, biased, NEG_INF), TOP_K)
    wts = jnp.take_along_axis(scores, idx, axis=1)
    wts = wts / jnp.sum(wts, axis=-1, keepdims=True) * ROUTED_SCALE

    A = T * TOP_K
    e_flat = idx.reshape(-1)
    tok_flat = jnp.repeat(jnp.arange(T, dtype=jnp.int32), TOP_K)
    w_flat = wts.reshape(-1)
    order = jnp.argsort(e_flat)
    e_sorted = e_flat[order]
    counts = jnp.bincount(e_flat, length=N_EXPERTS)
    padded = ((counts + MOE_BLOCK - 1) // MOE_BLOCK) * MOE_BLOCK
    pend = jnp.cumsum(padded)
    pstart = pend - padded
    start = jnp.cumsum(counts) - counts
    dest = pstart[e_sorted] + jnp.arange(A) - start[e_sorted]
    nblk = -(-A // MOE_BLOCK) + N_EXPERTS
    rows_tok = jnp.full((nblk * MOE_BLOCK,), T, jnp.int32).at[dest].set(tok_flat[order])
    rows_w = jnp.zeros((nblk * MOE_BLOCK,), jnp.float32).at[dest].set(w_flat[order])
    block_e = jnp.clip(jnp.searchsorted(pend, jnp.arange(nblk) * MOE_BLOCK, side="right"),
                       0, N_EXPERTS - 1)
    h_pad = jnp.concatenate([h, jnp.zeros((1, D), h.dtype)], axis=0)

    def expert_block(acc, blk):
        rt, rw, e = blk
        xb = h_pad[rt]
        a = jax.nn.silu(xb @ w_g[e]) * (xb @ w_u[e])
        yb = (a @ w_d[e]).astype(jnp.float32) * rw[:, None]
        return acc.at[rt].add(yb), None

    acc, _ = lax.scan(expert_block, jnp.zeros((T + 1, D), jnp.float32),
                      (rows_tok.reshape(nblk, MOE_BLOCK), rows_w.reshape(nblk, MOE_BLOCK), block_e))
    routed = acc[:T].astype(h.dtype)
    shared = (jax.nn.silu(h @ ws_g) * (h @ ws_u)) @ ws_d
    return routed + shared


def setup_inputs(seed: int = 0) -> dict:
    key = jax.random.key(seed)
    ks = jax.random.split(key, 32)
    f32 = jnp.float32
    D, L, A, C, E, F = D_MODEL, DEPTH, ATTN_WIDTH, CONV_WIDTH, N_EXPERTS, EXPERT_DIM

    def nrm(k, shape, scale):
        return jax.random.normal(k, shape, f32) * scale

    def gain(k, shape):
        return 1.0 + 0.02 * jax.random.normal(k, shape, f32)

    offs = jax.random.randint(ks[2], (BATCH, 1), 0, 4096)
    positions = (offs + jnp.arange(SEQ, dtype=jnp.int32)[None, :]).astype(jnp.int32)
    return {
        "x": nrm(ks[0], (BATCH, SEQ, D), 1.0),
        "c": nrm(ks[1], (BATCH, D), 1.0),
        "positions": positions,
        "g_norm1": gain(ks[3], (L, D)),
        "w_ada": nrm(ks[4], (L, D, 6 * D), 0.5 * D ** -0.5),
        "b_ada": nrm(ks[5], (L, 6 * D), 0.02),
        "w_in": nrm(ks[6], (L, D, IN_PROJ_WIDTH), D ** -0.5),
        "w_dw": nrm(ks[7], (L, CONV_KERNEL, C), CONV_KERNEL ** -0.5),
        "b_dw": nrm(ks[8], (L, C), 0.02),
        "g_conv_ln": gain(ks[9], (L, C)),
        "b_conv_ln": nrm(ks[10], (L, C), 0.02),
        "w_pw2": nrm(ks[11], (L, C, C), C ** -0.5),
        "b_pw2": nrm(ks[12], (L, C), 0.02),
        "g_attn_out": gain(ks[13], (L, A)),
        "g_conv_out": gain(ks[14], (L, C)),
        "w_out": nrm(ks[15], (L, A + C, D), (A + C) ** -0.5),
        "g_norm2": gain(ks[16], (L, D)),
        "w_router": nrm(ks[17], (L, D, E), D ** -0.5),
        "b_router": nrm(ks[18], (L, E), 0.01),
        "w_exp_gate": nrm(ks[19], (L, E, D, F), D ** -0.5),
        "w_exp_up": nrm(ks[20], (L, E, D, F), D ** -0.5),
        "w_exp_down": nrm(ks[21], (L, E, F, D), F ** -0.5),
        "w_sh_gate": nrm(ks[22], (L, D, SHARED_DIM), D ** -0.5),
        "w_sh_up": nrm(ks[23], (L, D, SHARED_DIM), D ** -0.5),
        "w_sh_down": nrm(ks[24], (L, SHARED_DIM, D), SHARED_DIM ** -0.5),
        "g_final": gain(ks[25], (D,)),
    }


def reference(x, c, positions, g_norm1, w_ada, b_ada, w_in, w_dw, b_dw, g_conv_ln, b_conv_ln,
              w_pw2, b_pw2, g_attn_out, g_conv_out, w_out, g_norm2, w_router, b_router,
              w_exp_gate, w_exp_up, w_exp_down, w_sh_gate, w_sh_up, w_sh_down, g_final):
    bsz, seq, d = x.shape
    A, C = ATTN_WIDTH, CONV_WIDTH
    for l in range(DEPTH):
        ada = (jax.nn.silu(c) @ w_ada[l] + b_ada[l])[:, None, :]
        sh1, sc1, gt1, sh2, sc2, gt2 = jnp.split(ada, 6, axis=-1)

        h = rms_norm(x, g_norm1[l]) * (1.0 + sc1) + sh1
        proj = h @ w_in[l]
        q, k, v, cu, cg = jnp.split(proj, [A, 2 * A, 3 * A, 3 * A + C], axis=-1)
        heads = lambda t: t.reshape(bsz, seq, N_ATTN_HEADS, HEAD_DIM).astype(jnp.float32)
        qh = partial_rotary(heads(q), positions)
        kh = partial_rotary(heads(k), positions)
        vh = heads(v)
        branches = [dilated_window_attention(qh, kh, vh, w, dl) for (w, dl) in DILATED_BRANCHES]
        o_all = jnp.stack([b[0] for b in branches], axis=0)
        alpha = jax.nn.softmax(jnp.stack([b[1] for b in branches], axis=0), axis=0)
        attn = jnp.sum(alpha[..., None] * o_all, axis=0).reshape(bsz, seq, A).astype(x.dtype)

        conv = conformer_conv(cu, cg, w_dw[l], b_dw[l], g_conv_ln[l], b_conv_ln[l],
                              w_pw2[l], b_pw2[l])

        mixed = jnp.concatenate([rms_norm(attn, g_attn_out[l]), rms_norm(conv, g_conv_out[l])],
                                axis=-1) @ w_out[l]
        x = x + gt1 * mixed

        h2 = rms_norm(x, g_norm2[l]) * (1.0 + sc2) + sh2
        y = moe_ffn(h2.reshape(bsz * seq, d), w_router[l], b_router[l], w_exp_gate[l],
                    w_exp_up[l], w_exp_down[l], w_sh_gate[l], w_sh_up[l], w_sh_down[l])
        x = x + gt2 * y.reshape(bsz, seq, d)
    return rms_norm(x, g_final)
```

```cpp
#include <hip/hip_runtime.h>
#include <stdint.h>
#include <stdio.h>

#ifndef MK_N_LAUNCHES
#define MK_N_LAUNCHES 1
#endif

#ifndef PROBE_PH
#define PROBE_PH (-1)
#endif

#define LAS __attribute__((address_space(3)))
typedef unsigned short bf16_t;
typedef short bf16x8 __attribute__((ext_vector_type(8)));
typedef float f32x4 __attribute__((ext_vector_type(4)));
typedef float f32x2 __attribute__((ext_vector_type(2)));
typedef unsigned u32x4 __attribute__((ext_vector_type(4)));
typedef unsigned u32x2 __attribute__((ext_vector_type(2)));

constexpr int NB = 4, SEQ = 8192, DM = 1024, NT = NB * SEQ;
constexpr int AW = 512, CW = 512, NHEAD = 8, HD = 64, NPROJ = 2560;
constexpr int NEXP = 256, TOPK = 8, FE = 256, CONVK = 31;
constexpr int NSLOT_MAX = NT * TOPK + NEXP * 256;
constexpr float NORM_EPS = 1e-6f;

constexpr size_t al256(size_t x) { return (x + 255) & ~(size_t)255; }
constexpr size_t WS_CTL   = 0;
constexpr size_t CTL_BYTES = 196608;
constexpr size_t WS_ADA   = WS_CTL + CTL_BYTES;
constexpr size_t WS_ROPE  = WS_ADA + al256((size_t)NB * 6144 * 4);
constexpr size_t WS_IDX   = WS_ROPE + (size_t)NT * 16 * 4;
constexpr size_t WS_RW    = WS_IDX + (size_t)NT * 8 * 4;
constexpr size_t WS_POS   = WS_RW + (size_t)NT * 8 * 4;
constexpr size_t WS_AIDS  = WS_POS + (size_t)NT * 8 * 4;
constexpr size_t WS_RWS   = WS_AIDS + (size_t)NSLOT_MAX * 4;
constexpr size_t WS_TEXP  = WS_RWS + (size_t)NSLOT_MAX * 4;
constexpr size_t WS_WDT   = WS_TEXP + 8192;
constexpr size_t WS_HBUF  = WS_WDT + (size_t)257 * 1024 * 256;
constexpr size_t WS_X1B   = WS_HBUF + (size_t)(NSLOT_MAX + NT) * 256;
constexpr size_t WS_OV    = WS_X1B + (size_t)NT * 1024 * 2;
constexpr size_t WS_WGU   = WS_OV;
constexpr size_t WS_WIN   = WS_WGU + (size_t)257 * 512 * 1024;
constexpr size_t WS_WOUT  = WS_WIN + (size_t)2560 * 1024 * 2;
constexpr size_t WS_WPW2  = WS_WOUT + (size_t)1024 * 1024 * 2;
constexpr size_t WS_WR    = WS_WPW2 + (size_t)512 * 512 * 2;
constexpr size_t WS_HB    = WS_WR + (size_t)256 * 1024 * 2;
constexpr size_t WS_QKV   = WS_HB + (size_t)NT * 1024 * 2;
constexpr size_t WS_AB    = WS_QKV + (size_t)3 * NT * 512 * 2;
constexpr size_t WS_OB    = WS_AB + (size_t)NT * 512 * 2;
constexpr size_t WS_LSE   = WS_OB + (size_t)3 * NT * 512 * 2;
constexpr size_t WS_ZB    = WS_LSE + (size_t)3 * NT * 8 * 4;
constexpr size_t WS_H2F8  = WS_ZB + (size_t)NT * 512 * 2;
constexpr size_t WS_OVEND = WS_H2F8 + (size_t)NT * 1024;
constexpr size_t WS_YBUF  = WS_OV;
constexpr size_t WS_YEND  = WS_YBUF + (size_t)NT * 9 * 1024;
constexpr size_t WS_END   = WS_OVEND > WS_YEND ? WS_OVEND : WS_YEND;
static_assert(WS_END <= (size_t)1 << 30, "workspace plan must fit 1 GiB");

constexpr int CW_BAR = 0;
constexpr int CW_GCNT = 8192;
constexpr int CW_NTILES = 4096 + 256;
constexpr int CW_PANEL2 = 32768;
constexpr int CW_PANEL = 16384;

constexpr int LDS_STAGE = 131072;
constexpr int LDS_BAR_OFF = LDS_STAGE;
constexpr int LDS_XCH_OFF = LDS_STAGE + 64;
constexpr int LDS_BYTES = 155648;

__device__ __forceinline__ unsigned pk_bf16(float lo, float hi) { unsigned r; asm volatile("v_cvt_pk_bf16_f32 %0, %1, %2" : "=v"(r) : "v"(lo), "v"(hi)); return r; }
__device__ __forceinline__ unsigned pk4_fp8(float a, float b, float c, float d) { int w = __builtin_amdgcn_cvt_pk_fp8_f32(a, b, 0, false); w = __builtin_amdgcn_cvt_pk_fp8_f32(c, d, w, true); return (unsigned)w; }
__device__ __forceinline__ float bf_lo(unsigned w) { return __uint_as_float(w << 16); }
__device__ __forceinline__ float bf_hi(unsigned w) { return __uint_as_float(w & 0xffff0000u); }
__device__ __forceinline__ float sigmoid_fast(float x) { return __builtin_amdgcn_rcpf(1.0f + __expf(-x)); }
__device__ __forceinline__ float silu_fast(float x) { return x * __builtin_amdgcn_rcpf(1.0f + __expf(-x)); }
__device__ __forceinline__ float wave_sum(float v) {
#pragma unroll
    for (int o = 32; o > 0; o >>= 1) v += __shfl_xor(v, o);
    return v;
}

#define XB_TMO      128
#define XB_XCNT(j)  (256  + 64 * (j))
#define XB_XSUB(j)  (1280 + 64 * (j))
#define XB_XGEN(j)  (2304 + 64 * (j))
#define XB_TOP      3328
#define XB_TOPGEN   3392
#define XCD_BAR_WORDS 3456
#define XB_SPIN_CAP (1u << 18)

__device__ __forceinline__ unsigned xb_ld(unsigned* p)              { return __hip_atomic_load(p, __ATOMIC_RELAXED, __HIP_MEMORY_SCOPE_AGENT); }
__device__ __forceinline__ unsigned xb_add(unsigned* p, unsigned v) { return __hip_atomic_fetch_add(p, v, __ATOMIC_RELAXED, __HIP_MEMORY_SCOPE_AGENT); }
__device__ __forceinline__ unsigned xb_xcc_id() { return (unsigned)__builtin_amdgcn_s_getreg((3 << 11) | 20) & 0xFu; }
#define XB_SPIN(cond, bar) do { unsigned _sp = 0; while (cond) { __builtin_amdgcn_s_sleep(1); \
    if ((++_sp & 255u) == 0u) { if (xb_ld(&(bar)[XB_TMO])) break; if (_sp > XB_SPIN_CAP) { atomicAdd(&(bar)[XB_TMO], 1u); break; } } } } while (0)

struct XcdBarrier { unsigned* bar; unsigned x; volatile LAS unsigned* st; };

__device__ __forceinline__ XcdBarrier xcd_barrier_post(unsigned* bar, volatile LAS unsigned* st) {
    XcdBarrier b; b.bar = bar; b.x = xb_xcc_id(); b.st = st;
    if (threadIdx.x == 0) (void)xb_add(&bar[XB_XCNT(b.x)], 1u);
    return b;
}
__device__ __forceinline__ void xcd_barrier_complete(unsigned* bar, unsigned x, unsigned& nloc, unsigned& nx) {
    const unsigned G = gridDim.x * gridDim.y * gridDim.z;
    unsigned sum, cnt, mine, sp = 0u;
    for (;;) {
        sum = 0u; cnt = 0u; mine = 0u;
#pragma unroll
        for (unsigned j = 0; j < 16; ++j) { const unsigned c = xb_ld(&bar[XB_XCNT(j)]); sum += c; cnt += (c > 0u) ? 1u : 0u; mine = (j == x) ? c : mine; }
        if (sum == G) break;
        __builtin_amdgcn_s_sleep(1);
        if ((++sp & 255u) == 0u) { if (xb_ld(&bar[XB_TMO])) break; if (sp > XB_SPIN_CAP) { atomicAdd(&bar[XB_TMO], 1u); break; } }
    }
    nloc = mine > 0u ? mine : 1u; nx = cnt > 0u ? cnt : 1u;
}
__device__ __forceinline__ void xcd_barrier(const XcdBarrier& b) {
    asm volatile("s_waitcnt vmcnt(0)" ::: "memory");
    __syncthreads();
    if (threadIdx.x == 0) {
        unsigned* bar = b.bar;
        __builtin_amdgcn_s_waitcnt(0);
        unsigned nloc = b.st[0], nx = b.st[1];
        if (nloc == 0u) { xcd_barrier_complete(bar, b.x, nloc, nx); b.st[0] = nloc; b.st[1] = nx; }
        const unsigned old = xb_add(&bar[XB_XSUB(b.x)], 1u);
        const unsigned gen = old / nloc;
        if (old + 1u == (gen + 1u) * nloc) {
            __builtin_amdgcn_fence(__ATOMIC_RELEASE, "agent");
            asm volatile("s_waitcnt vmcnt(0)" ::: "memory");
            const unsigned og = xb_add(&bar[XB_TOP], 1u);
            const unsigned tg = og / nx;
            if (og + 1u == (tg + 1u) * nx) xb_add(&bar[XB_TOPGEN], 1u);
            else XB_SPIN(xb_ld(&bar[XB_TOPGEN]) == tg, bar);
            __builtin_amdgcn_fence(__ATOMIC_ACQUIRE, "agent");
            xb_add(&bar[XB_XGEN(b.x)], 1u);
            asm volatile("s_waitcnt vmcnt(0)" ::: "memory");
        } else {
            XB_SPIN(xb_ld(&bar[XB_XGEN(b.x)]) == gen, bar);
            __builtin_amdgcn_fence(__ATOMIC_ACQUIRE, "agent");
            asm volatile("s_waitcnt vmcnt(0)" ::: "memory");
        }
    }
    __syncthreads();
}

constexpr int BM = 256, BK = 64, HALF = 128, HTB = HALF * BK * 2, NXCD = 8, WGM = 8;

__host__ __device__ __forceinline__ int lds_byte(int r, int c) { const int st = (r >> 4) * 2 + (c >> 5), rr = r & 15, cc = c & 31, ob = rr * 64 + cc * 2; return st * 1024 + (ob ^ (((ob >> 9) & 1) << 5)); }
__host__ __device__ __forceinline__ void stage_rc(int b, int& R, int& C) { const int st = b / 1024, sb = b % 1024, swz = sb ^ (((sb >> 9) & 1) << 5); R = (st >> 1) * 16 + swz / 64; C = (st & 1) * 32 + (swz % 64) / 2; }
__host__ __device__ __forceinline__ int perm32(int rho) { const int n = rho >> 4, i = rho & 15; return 8 * (i >> 2) + 4 * n + (i & 3); }

__host__ __device__ __forceinline__ int g8(int r16) { const int h = r16 >> 1; return (h < 2) ? h : (h < 6 ? h + 2 : h - 4); }
struct Unit { int pm, pn, e, kind; };

struct GemmDense {
    static constexpr bool F8 = false, GATHER = false;
    const char* A; const char* Bt; int M, N, KB, ldaB; int G, c;
    __device__ __forceinline__ bool next(int i, Unit& u) const {
        const int nM = M / BM, nN = N / BM, nwg = nM * nN;
        const long L = (long)i * G + c; if (L >= nwg) return false;
        int wgid = (int)L; { const int q = nwg / NXCD, r = nwg % NXCD, xcd = wgid % NXCD, off = wgid / NXCD; wgid = (xcd < r ? xcd * (q + 1) : r * (q + 1) + (xcd - r) * q) + off; }
        const int nig = WGM * nN, gid = wgid / nig, fm = gid * WGM, gsz = (nM - fm) < WGM ? (nM - fm) : WGM;
        u.pm = fm + ((wgid % nig) % gsz); u.pn = (wgid % nig) / gsz; u.e = i; u.kind = 0; return true;
    }
    __device__ __forceinline__ const char* a_base() const { return A; }
    __device__ __forceinline__ void a_off(const Unit& u, unsigned (&off)[2][2]) const {
        int tz = threadIdx.x; asm volatile("" : "+v"(tz));
#pragma unroll
        for (int i = 0; i < 2; ++i) { int R, C; stage_rc(tz * 16 + i * 8192, R, C);
#pragma unroll
            for (int h = 0; h < 2; ++h) off[h][i] = (unsigned)((size_t)(u.pm * BM + h * HALF + R) * ldaB + C * 2); }
    }
    __device__ __forceinline__ const char* b_ptr(const Unit& u) const { return Bt + (size_t)u.pn * BM * KB; }
    __device__ __forceinline__ const char* a_unit(const Unit& u) const { return A + (size_t)u.pm * BM * ldaB; }
    __device__ __forceinline__ int a_row_bytes() const { return ldaB; }
};

__device__ __forceinline__ int sload_i32(const int* p) { int v; asm volatile("s_load_dword %0, %1, 0x0\n\ts_waitcnt lgkmcnt(0)" : "=s"(v) : "s"(p) : "memory"); return v; }
struct GemmGU {
    static constexpr bool F8 = true, GATHER = true;
    const char* A; const char* W; const int* aids; const int* texp; int ntiles; int KB; int G, c; LAS unsigned char* idx;
    __device__ __forceinline__ bool next(int i, Unit& u) const {
        const int L = i * G + (((G & 7) == 0) ? (c & 7) * (G >> 3) + (c >> 3) : c); if (L >= (ntiles + NT / BM) * 2) return false;
        const int tile = L >> 1; u.pn = L & 1;
        if (tile < ntiles) { u.e = sload_i32(texp + tile); u.pm = tile * BM; u.kind = 0; } else { u.e = NEXP; u.pm = NSLOT_MAX + (tile - ntiles) * BM; u.kind = 1; }
        return true;
    }
    __device__ __forceinline__ const char* a_base() const { return A; }
    __device__ __forceinline__ void idx_issue(int upm, int ukind, int par, int wid) const {
        int tz = threadIdx.x; asm volatile("" : "+v"(tz)); const int lane = tz & 63;
        const int row = upm + (wid & 3) * 64 + lane;
        __builtin_amdgcn_global_load_lds((const unsigned*)(aids + (ukind == 0 ? row : lane)), (LAS unsigned*)(idx + par * 1024 + (wid & 3) * 256), 4, 0, 0);
    }
    __device__ __forceinline__ void a_off(const Unit& u, int par, unsigned (&off)[2][2]) const {
        int tz = threadIdx.x; asm volatile("" : "+v"(tz));
        const LAS int* ix = (const LAS int*)(idx + par * 1024);
        const bool sh = u.kind != 0;
#pragma unroll
        for (int i = 0; i < 2; ++i) { const int R = (tz >> 3) + 64 * i, C = 8 * ((tz & 7) ^ g8(R & 15));
#pragma unroll
            for (int h = 0; h < 2; ++h) { const int a = ix[h * HALF + R]; const int tok = sh ? u.pm + h * HALF + R - NSLOT_MAX : ((a < 0 ? 0 : a) >> 3);
                off[h][i] = (unsigned)((size_t)tok * DM + C * 2); } }
    }
    __device__ __forceinline__ const char* b_ptr(const Unit& u) const { return W + (size_t)(u.e * 2 + u.pn) * BM * DM; }
    __device__ __forceinline__ const char* a_unit(const Unit&) const { return A; }
    __device__ __forceinline__ int a_row_bytes() const { return DM; }
};
struct GemmDown {
    static constexpr bool F8 = true, GATHER = false;
    const char* A; const char* W; const int* texp; int ntiles; int KB; int G, c;
    __device__ __forceinline__ bool next(int i, Unit& u) const {
        const int L = i * G + (((G & 7) == 0) ? (c & 7) * (G >> 3) + (c >> 3) : c); if (L >= (ntiles + NT / BM) * 4) return false;
        const int tile = L >> 2; u.pn = L & 3;
        if (tile < ntiles) { u.e = sload_i32(texp + tile); u.pm = tile * BM; u.kind = 0; } else { u.e = NEXP; u.pm = NSLOT_MAX + (tile - ntiles) * BM; u.kind = 1; }
        return true;
    }
    __device__ __forceinline__ const char* a_base() const { return A; }
    __device__ __forceinline__ void a_off(const Unit& u, unsigned (&off)[2][2]) const {
        int tz = threadIdx.x; asm volatile("" : "+v"(tz));
#pragma unroll
        for (int i = 0; i < 2; ++i) { int R, C; stage_rc(tz * 16 + i * 8192, R, C);
#pragma unroll
            for (int h = 0; h < 2; ++h) off[h][i] = (unsigned)((size_t)(u.pm + h * HALF + R) * FE + C * 2); }
    }
    __device__ __forceinline__ const char* b_ptr(const Unit& u) const { return W + ((size_t)u.e * DM + (size_t)u.pn * BM) * FE; }
    __device__ __forceinline__ const char* a_unit(const Unit& u) const { return A + (size_t)u.pm * FE; }
    __device__ __forceinline__ int a_row_bytes() const { return FE; }
};

typedef int v8i_t __attribute__((ext_vector_type(8)));
template <bool F8> struct FragA { u32x4 v[4][2]; };
template <> struct FragA<true> { v8i_t v[4]; };
template <bool F8> struct FragB { u32x4 v[2][2]; };
template <> struct FragB<true> { v8i_t v[2]; };
constexpr float F8_WSCALE = 64.0f, F8_WINV = 1.0f / 64.0f;
template <class E, class = void> struct HasPf { static constexpr bool v = false; };
template <class E> struct HasPf<E, decltype((void)E::PF)> { static constexpr bool v = true; };
template <int MODE = 0, class P, class Epi>
__device__ __forceinline__ void gemm_phase(LAS unsigned char* lds, const P& p, const Epi& E) {
    const int tid = threadIdx.x, wid = __builtin_amdgcn_readfirstlane(tid >> 6), lane = tid & 63, wr = wid >> 2, wc = wid & 3, fr = lane & 15, fq = lane >> 4;
    constexpr bool DS = HasPf<Epi>::v && MODE == 0;
    const int KB = p.KB, nt = KB / 128;
    unsigned voffB;
    { int R, C; if constexpr (P::F8) { R = tid >> 3; C = 8 * ((tid & 7) ^ g8(R & 15)); } else stage_rc(tid * 16, R, C);
      const int Rb = Epi::PERM ? ((R & ~31) + perm32(R & 31)) : R; voffB = (unsigned)(Rb * KB + C * 2); }
    const size_t p1B = (size_t)64 * KB;
    const size_t kstep = 128;
    const size_t hstep = (size_t)HALF * KB;
    const unsigned ldsw = (unsigned)wid * 1024u;
    const int foff8 = fr * 128 + 16 * ((2 * fq) ^ g8(fr));
    const int aoff = P::F8 ? wr * 8192 + foff8 : lds_byte(wr * 64 + fr, fq * 8), boff = P::F8 ? wc * 4096 + foff8 : lds_byte(wc * 32 + fr, fq * 8);
    const int aoff2 = aoff ^ 16, boff2 = boff ^ 16;
#define G_SA(b, h) (((b) * 2 + (h)) * HTB)
#define G_SB(b, h) ((4 + (b) * 2 + (h)) * HTB)
#define G_STAGE2(bufoff, gbase, voff, kb) do { if constexpr (MODE != 3) _Pragma("unroll") for (int _i = 0; _i < 2; ++_i) \
        __builtin_amdgcn_global_load_lds((const unsigned*)((const char*)(gbase) + (unsigned)((voff)[_i] + (unsigned)(kb))), (LAS unsigned*)(lds + (bufoff) + ldsw + _i * 8192), 16, 0, 0); } while (0)
#define G_STAGE1(bufoff, gbase, voff, p1) do { if constexpr (MODE != 3) _Pragma("unroll") for (int _i = 0; _i < 2; ++_i) \
        __builtin_amdgcn_global_load_lds((const unsigned*)((const char*)(gbase) + _i * (p1) + (voff)), (LAS unsigned*)(lds + (bufoff) + ldsw + _i * 8192), 16, 0, 0); } while (0)
#define G_STAGE(bufoff, gbase, voff) G_STAGE1(bufoff, gbase, voff, p1B)
#define G_LDA(dst, b, h) do { _Pragma("unroll") for (int m = 0; m < 4; ++m) { if constexpr (P::F8) { const u32x4 lo_ = *(const LAS u32x4*)(lds + G_SA(b, h) + aoff + m * 2048), hi_ = *(const LAS u32x4*)(lds + G_SA(b, h) + aoff2 + m * 2048); dst.v[m] = (v8i_t){(int)lo_.x, (int)lo_.y, (int)lo_.z, (int)lo_.w, (int)hi_.x, (int)hi_.y, (int)hi_.z, (int)hi_.w}; } \
        else { _Pragma("unroll") for (int k = 0; k < 2; ++k) dst.v[m][k] = *(const LAS u32x4*)(lds + G_SA(b, h) + aoff + m * 2048 + k * 1024); } } } while (0)
#define G_LDB(dst, b, h) do { _Pragma("unroll") for (int n = 0; n < 2; ++n) { if constexpr (P::F8) { const u32x4 lo_ = *(const LAS u32x4*)(lds + G_SB(b, h) + boff + n * 2048), hi_ = *(const LAS u32x4*)(lds + G_SB(b, h) + boff2 + n * 2048); dst.v[n] = (v8i_t){(int)lo_.x, (int)lo_.y, (int)lo_.z, (int)lo_.w, (int)hi_.x, (int)hi_.y, (int)hi_.z, (int)hi_.w}; } \
        else { _Pragma("unroll") for (int k = 0; k < 2; ++k) dst.v[n][k] = *(const LAS u32x4*)(lds + G_SB(b, h) + boff + n * 2048 + k * 1024); } } } while (0)
#define G_MMA(ai, bj, At, Bt) do { if constexpr (MODE == 2) { _Pragma("unroll") for (int m = 0; m < 4; ++m) asm volatile("" :: "v"(At.v[m])); _Pragma("unroll") for (int n = 0; n < 2; ++n) asm volatile("" :: "v"(Bt.v[n])); } else { __builtin_amdgcn_s_setprio(1); _Pragma("unroll") for (int m = 0; m < 4; ++m) _Pragma("unroll") for (int n = 0; n < 2; ++n) { \
        if constexpr (P::F8) acc[ai][bj][m][n] = __builtin_amdgcn_mfma_scale_f32_16x16x128_f8f6f4(Bt.v[n], At.v[m], acc[ai][bj][m][n], 0, 0, 0, 0, 0, 0); \
        else { _Pragma("unroll") for (int k = 0; k < 2; ++k) acc[ai][bj][m][n] = __builtin_amdgcn_mfma_f32_16x16x32_bf16(__builtin_bit_cast(bf16x8, Bt.v[n][k]), __builtin_bit_cast(bf16x8, At.v[m][k]), acc[ai][bj][m][n], 0, 0, 0); } } \
        if constexpr (P::F8) { _Pragma("unroll") for (int m = 0; m < 4; ++m) _Pragma("unroll") for (int n = 0; n < 2; ++n) asm volatile("" : "+v"(acc[ai][bj][m][n])); } \
        __builtin_amdgcn_s_setprio(0); } } while (0)
#define G_WAIT_V(n) asm volatile("s_waitcnt vmcnt(" #n ")" ::: "memory")
#define G_WAIT_L(n) asm volatile("s_waitcnt lgkmcnt(" #n ")" ::: "memory")
#define G_BAR __builtin_amdgcn_s_barrier()
#define G_SCHED __builtin_amdgcn_sched_barrier(0)
    Unit cur, nxt; int ui = 0;
    if (!p.next(0, cur)) return;
    f32x4 acc[2][2][4][2];
#pragma unroll
    for (int a = 0; a < 2; ++a)
#pragma unroll
        for (int b = 0; b < 2; ++b)
#pragma unroll
            for (int m = 0; m < 4; ++m)
#pragma unroll
                for (int n = 0; n < 2; ++n) acc[a][b][m][n] = (f32x4){0.f, 0.f, 0.f, 0.f};
    FragA<P::F8> At; FragB<P::F8> B0, B1;
    unsigned ao_cur[2][2], ao_nxt[2][2], voffA = 0;
    const char* pA_cur = p.a_unit(cur); const char* pA_nxt = pA_cur;
    const size_t hstepA = (size_t)HALF * p.a_row_bytes();
    if constexpr (P::GATHER) { p.idx_issue(cur.pm, cur.kind, 0, wid); G_WAIT_V(0); G_BAR; p.a_off(cur, 0, ao_cur); }
    else { int R, C; if constexpr (P::F8) { R = tid >> 3; C = 8 * ((tid & 7) ^ g8(R & 15)); } else stage_rc(tid * 16, R, C); voffA = (unsigned)(R * p.a_row_bytes() + C * 2); }
    const size_t p1A = (size_t)64 * p.a_row_bytes();
#define G_STAGE_A(bufoff, U, h, kb) do { if constexpr (P::GATHER) G_STAGE2(bufoff, pA_cur, ao_##U[h], kb); else G_STAGE1(bufoff, pA_##U + (h) * hstepA + (kb), voffA, p1A); } while (0)
    const char* cB = p.b_ptr(cur);
    G_STAGE(G_SB(0, 0), cB, voffB); G_STAGE_A(G_SA(0, 0), cur, 0, 0); G_STAGE(G_SB(0, 1), cB + hstep, voffB); G_STAGE_A(G_SA(0, 1), cur, 1, 0);
    if (wr == 1) G_BAR;
    G_WAIT_V(4); G_BAR;
    G_STAGE(G_SB(1, 0), cB + kstep, voffB); G_STAGE_A(G_SA(1, 0), cur, 0, kstep); G_STAGE(G_SB(1, 1), cB + hstep + kstep, voffB);
    if constexpr (DS) { G_STAGE_A(G_SA(1, 1), cur, 1, kstep); E.pf_issue(cur.pm, cur.kind, 0, wr, wc); G_WAIT_V(0); G_BAR; }
    else { G_WAIT_V(6); G_BAR; }
#define G_TRIP(K1, U2, K2, B2) do { \
            G_LDB(B0, 0, 0); G_SCHED; G_LDA(At, 0, 0); G_STAGE_A(G_SA(1, 1), cur, 1, (K1)); \
            G_WAIT_L(8); G_BAR; G_WAIT_L(0); G_MMA(0, 0, At, B0); G_BAR; G_SCHED; \
            G_LDB(B1, 0, 1); G_STAGE(G_SB(0, 0), (B2), voffB); \
            G_BAR; G_WAIT_L(0); G_MMA(0, 1, At, B1); G_BAR; \
            G_LDA(At, 0, 1); G_STAGE_A(G_SA(0, 0), U2, 0, (K2)); \
            G_BAR; G_WAIT_L(0); G_MMA(1, 0, At, B0); G_BAR; G_SCHED; \
            G_STAGE(G_SB(0, 1), (B2) + hstep, voffB); \
            G_WAIT_V(6); G_BAR; G_MMA(1, 1, At, B1); G_BAR; \
            G_LDB(B0, 1, 0); G_SCHED; G_LDA(At, 1, 0); G_STAGE_A(G_SA(0, 1), U2, 1, (K2)); \
            G_WAIT_L(8); G_BAR; G_WAIT_L(0); G_MMA(0, 0, At, B0); G_BAR; G_SCHED; \
            G_LDB(B1, 1, 1); G_STAGE(G_SB(1, 0), (B2) + kstep, voffB); \
            G_BAR; G_WAIT_L(0); G_MMA(0, 1, At, B1); G_BAR; \
            G_LDA(At, 1, 1); G_STAGE_A(G_SA(1, 0), U2, 0, (K2) + kstep); \
            G_BAR; G_WAIT_L(0); G_MMA(1, 0, At, B0); G_BAR; G_SCHED; \
            G_STAGE(G_SB(1, 1), (B2) + kstep + hstep, voffB); \
            G_WAIT_V(6); G_BAR; G_MMA(1, 1, At, B1); G_BAR; } while (0)
#define G_TRIP_D(B2) do { \
            G_LDB(B0, 0, 0); G_SCHED; G_LDA(At, 0, 0); \
            G_WAIT_L(8); G_BAR; G_WAIT_L(0); G_MMA(0, 0, At, B0); G_BAR; G_SCHED; \
            G_LDB(B1, 0, 1); G_STAGE(G_SB(0, 0), (B2), voffB); \
            G_BAR; G_WAIT_L(0); G_MMA(0, 1, At, B1); G_BAR; \
            G_LDA(At, 0, 1); G_STAGE_A(G_SA(0, 0), nxt, 0, (size_t)0); \
            G_BAR; G_WAIT_L(0); G_MMA(1, 0, At, B0); G_BAR; G_SCHED; \
            G_STAGE(G_SB(0, 1), (B2) + hstep, voffB); \
            G_WAIT_V(15); G_BAR; G_MMA(1, 1, At, B1); G_BAR; \
            G_LDB(B0, 1, 0); G_SCHED; G_LDA(At, 1, 0); G_STAGE_A(G_SA(0, 1), nxt, 1, (size_t)0); \
            G_WAIT_L(8); G_BAR; G_WAIT_L(0); G_MMA(0, 0, At, B0); G_BAR; G_SCHED; \
            G_LDB(B1, 1, 1); G_STAGE(G_SB(1, 0), (B2) + kstep, voffB); \
            G_BAR; G_WAIT_L(0); G_MMA(0, 1, At, B1); G_BAR; \
            G_LDA(At, 1, 1); G_STAGE_A(G_SA(1, 0), nxt, 0, kstep); \
            G_BAR; G_WAIT_L(0); G_MMA(1, 0, At, B0); G_BAR; G_SCHED; \
            G_STAGE(G_SB(1, 1), (B2) + kstep + hstep, voffB); \
            G_BAR; G_MMA(1, 1, At, B1); G_BAR; \
            G_STAGE_A(G_SA(1, 1), nxt, 1, kstep); } while (0)
    for (;;) {
        const bool has_next = p.next(ui + 1, nxt);
        if constexpr (P::GATHER) p.idx_issue(has_next ? nxt.pm : cur.pm, has_next ? nxt.kind : cur.kind, (ui + 1) & 1, wid);
        for (int t = 0; t < nt - 2; t += 2) {
            const size_t k1 = (size_t)(t + 1) * kstep;
            G_TRIP(k1, cur, k1 + kstep, cB + k1 + kstep);
        }
        const char* nB = cB;
        if (has_next) { if constexpr (P::GATHER) p.a_off(nxt, (ui + 1) & 1, ao_nxt); else pA_nxt = p.a_unit(nxt); nB = p.b_ptr(nxt); }
        else { if constexpr (P::GATHER) {
#pragma unroll
            for (int h = 0; h < 2; ++h)
#pragma unroll
                for (int i = 0; i < 2; ++i) ao_nxt[h][i] = ao_cur[h][i]; } else pA_nxt = pA_cur; }
        if constexpr (DS) { E.pf_issue(has_next ? nxt.pm : cur.pm, has_next ? nxt.kind : cur.kind, (ui + 1) & 1, wr, wc); G_TRIP_D(nB); }
        else G_TRIP((size_t)(nt - 1) * kstep, nxt, (size_t)0, nB);
        if (wr == 0) G_BAR;
        { int tz = threadIdx.x; asm volatile("" : "+v"(tz)); const int l2 = tz & 63; if constexpr (MODE == 0) { if constexpr (DS) E(acc, cur, wr, wc, l2 & 15, l2 >> 4, ui & 1); else E(acc, cur, wr, wc, l2 & 15, l2 >> 4); } else { _Pragma("unroll") for (int a_ = 0; a_ < 2; ++a_) _Pragma("unroll") for (int b_ = 0; b_ < 2; ++b_) _Pragma("unroll") for (int m_ = 0; m_ < 4; ++m_) _Pragma("unroll") for (int n_ = 0; n_ < 2; ++n_) asm volatile("" :: "v"(acc[a_][b_][m_][n_])); } }
        if (!has_next) break;
        if constexpr (DS) { G_WAIT_V(16); G_BAR; }
        if (wr == 1) G_BAR;
#pragma unroll
        for (int a = 0; a < 2; ++a)
#pragma unroll
            for (int b = 0; b < 2; ++b)
#pragma unroll
                for (int m = 0; m < 4; ++m)
#pragma unroll
                    for (int n = 0; n < 2; ++n) acc[a][b][m][n] = (f32x4){0.f, 0.f, 0.f, 0.f};
        if constexpr (P::GATHER) {
#pragma unroll
            for (int h = 0; h < 2; ++h)
#pragma unroll
                for (int i = 0; i < 2; ++i) ao_cur[h][i] = ao_nxt[h][i]; } else pA_cur = pA_nxt;
        cur = nxt; cB = nB; ++ui;
    }
    G_WAIT_V(0);
    G_BAR;
#undef G_TRIP
#undef G_TRIP_D
#undef G_STAGE_A
#undef G_SA
#undef G_SB
#undef G_STAGE
#undef G_STAGE1
#undef G_STAGE2
#undef G_LDA
#undef G_LDB
#undef G_MMA
}

typedef f32x4 Acc[2][2][4][2];

struct EpiF32 {
    static constexpr bool PERM = false;
    float* C; int ldc;
    __device__ __forceinline__ void operator()(const Acc& acc, const Unit& u, int wr, int wc, int fr, int fq) const {
        const int row0 = u.pm * BM + wr * 64 + fr, col0 = u.pn * BM + wc * 32 + 4 * fq;
#pragma unroll
        for (int ai = 0; ai < 2; ++ai)
#pragma unroll
            for (int m = 0; m < 4; ++m) { float* rowp = C + (size_t)(row0 + ai * HALF + m * 16) * ldc + col0;
#pragma unroll
                for (int bj = 0; bj < 2; ++bj)
#pragma unroll
                    for (int n = 0; n < 2; ++n) *(f32x4*)(rowp + bj * HALF + n * 16) = acc[ai][bj][m][n]; }
    }
};
struct EpiBf16Bias {
    static constexpr bool PERM = true;
    bf16_t* O; int ldc; const float* bias;
    __device__ __forceinline__ void operator()(const Acc& acc, const Unit& u, int wr, int wc, int fr, int fq) const {
        const int row0 = u.pm * BM + wr * 64 + fr, col0 = u.pn * BM + wc * 32 + 8 * fq;
        f32x4 bv[2][2];
#pragma unroll
        for (int bj = 0; bj < 2; ++bj)
#pragma unroll
            for (int n = 0; n < 2; ++n) bv[bj][n] = *(const f32x4*)(bias + col0 + bj * HALF + 4 * n);
#pragma unroll
        for (int ai = 0; ai < 2; ++ai)
#pragma unroll
            for (int m = 0; m < 4; ++m) { bf16_t* rowp = O + (size_t)(row0 + ai * HALF + m * 16) * ldc + col0;
#pragma unroll
                for (int bj = 0; bj < 2; ++bj) { const f32x4 v0 = acc[ai][bj][m][0] + bv[bj][0], v1 = acc[ai][bj][m][1] + bv[bj][1];
                    u32x4 w; w.x = pk_bf16(v0[0], v0[1]); w.y = pk_bf16(v0[2], v0[3]); w.z = pk_bf16(v1[0], v1[1]); w.w = pk_bf16(v1[2], v1[3]);
                    *(u32x4*)(rowp + bj * HALF) = w; } }
    }
};
struct EpiInProj {
    static constexpr bool PERM = true;
    bf16_t* qkv; bf16_t* abuf; const float* rope;
    __device__ __forceinline__ void operator()(const Acc& acc, const Unit& u, int wr, int wc, int fr, int fq) const {
        const int row0 = u.pm * BM + wr * 64 + fr;
        if (u.pn < 6) {
            const int which = u.pn >> 1;
            const bool rot = (which < 2) && ((wc & 1) == 0);
            const float qs = (which == 0) ? 0.125f : 1.0f;
            bf16_t* dst = qkv + (size_t)which * NT * AW;
            const float sg = (fq == 0) ? -1.0f : 1.0f;
            f32x4 ra[4], rb[4];
#define IP_LOAD(dst_, g) do { const float* rp_ = rope + (size_t)(row0 + ((g) >> 2) * HALF + ((g) & 3) * 16) * 16; _Pragma("unroll") for (int j_ = 0; j_ < 4; ++j_) dst_[j_] = *(const f32x4*)(rp_ + 4 * j_); } while (0)
#define IP_GROUP(ROT, cs_, g) do { const int ai = (g) >> 2, m = (g) & 3; const int row = row0 + ai * HALF + m * 16, b = row >> 13, s = row & (SEQ - 1); \
                _Pragma("unroll") for (int bj = 0; bj < 2; ++bj) { float v[8]; \
                    _Pragma("unroll") for (int j = 0; j < 4; ++j) { v[j] = acc[ai][bj][m][0][j]; v[4 + j] = acc[ai][bj][m][1][j]; } \
                    if (ROT) { _Pragma("unroll") for (int j = 0; j < 8; ++j) { const float pv = __shfl_xor(v[j], 16); const float r = v[j] * cs_[j >> 2][j & 3] + sg * pv * cs_[2 + (j >> 2)][j & 3]; v[j] = (fq < 2) ? r : v[j]; } } \
                    const int head = (u.pn & 1) * 4 + 2 * bj + (wc >> 1), colh = 32 * (wc & 1) + 8 * fq; \
                    u32x4 w; w.x = pk_bf16(v[0] * qs, v[1] * qs); w.y = pk_bf16(v[2] * qs, v[3] * qs); w.z = pk_bf16(v[4] * qs, v[5] * qs); w.w = pk_bf16(v[6] * qs, v[7] * qs); \
                    *(u32x4*)(dst + ((size_t)(b * NHEAD + head) * SEQ + s) * HD + colh) = w; } } while (0)
            if (rot) {
                IP_LOAD(ra, 0);
#pragma unroll
                for (int g = 0; g < 8; g += 2) {
                    IP_LOAD(rb, g + 1);
                    asm volatile("" ::: "memory");
                    IP_GROUP(true, ra, g);
                    if (g + 2 < 8) IP_LOAD(ra, g + 2);
                    asm volatile("" ::: "memory");
                    IP_GROUP(true, rb, g + 1);
                }
            } else {
#pragma unroll
                for (int g = 0; g < 8; ++g) IP_GROUP(false, ra, g);
            }
#undef IP_LOAD
#undef IP_GROUP
        } else {
            const int ch0 = (u.pn - 6) * 128 + wc * 32 + 8 * fq;
#pragma unroll
            for (int ai = 0; ai < 2; ++ai)
#pragma unroll
                for (int m = 0; m < 4; ++m) {
                    const int row = row0 + ai * HALF + m * 16;
                    float v[8];
#pragma unroll
                    for (int j = 0; j < 4; ++j) { v[j] = acc[ai][0][m][0][j] * sigmoid_fast(acc[ai][1][m][0][j]); v[4 + j] = acc[ai][0][m][1][j] * sigmoid_fast(acc[ai][1][m][1][j]); }
                    u32x4 w; w.x = pk_bf16(v[0], v[1]); w.y = pk_bf16(v[2], v[3]); w.z = pk_bf16(v[4], v[5]); w.w = pk_bf16(v[6], v[7]);
                    *(u32x4*)(abuf + (size_t)row * CW + ch0) = w;
                }
        }
    }
};
struct EpiOut {
    static constexpr bool PERM = true;
    const float* __restrict__ x; bf16_t* __restrict__ x1; const float* __restrict__ gate;
    __device__ __forceinline__ void operator()(const Acc& acc, const Unit& u, int wr, int wc, int fr, int fq) const {
        const int row0 = u.pm * BM + wr * 64 + fr, col0 = u.pn * BM + wc * 32 + 8 * fq;
        const int b = (u.pm * BM) >> 13;
        f32x4 gv[2][2];
#pragma unroll
        for (int bj = 0; bj < 2; ++bj)
#pragma unroll
            for (int n = 0; n < 2; ++n) gv[bj][n] = *(const f32x4*)(gate + (size_t)b * 6144 + col0 + bj * HALF + n * 4);
        f32x4 xa[2][2], xb[2][2];
#define EO_LOAD(dst, g) do { const size_t off_ = (size_t)(row0 + ((g) >> 2) * HALF + ((g) & 3) * 16) * DM + col0; _Pragma("unroll") for (int bj = 0; bj < 2; ++bj) _Pragma("unroll") for (int n = 0; n < 2; ++n) dst[bj][n] = *(const f32x4*)(x + off_ + bj * HALF + n * 4); } while (0)
#define EO_STORE(srcv, g) do { const size_t off_ = (size_t)(row0 + ((g) >> 2) * HALF + ((g) & 3) * 16) * DM + col0; _Pragma("unroll") for (int bj = 0; bj < 2; ++bj) { \
            const f32x4 v0 = srcv[bj][0] + gv[bj][0] * acc[(g) >> 2][bj][(g) & 3][0], v1 = srcv[bj][1] + gv[bj][1] * acc[(g) >> 2][bj][(g) & 3][1]; \
            u32x4 w; w.x = pk_bf16(v0[0], v0[1]); w.y = pk_bf16(v0[2], v0[3]); w.z = pk_bf16(v1[0], v1[1]); w.w = pk_bf16(v1[2], v1[3]); *(u32x4*)(x1 + off_ + bj * HALF) = w; } } while (0)
        EO_LOAD(xa, 0);
#pragma unroll
        for (int g = 0; g < 8; g += 2) {
            EO_LOAD(xb, g + 1);
            asm volatile("" ::: "memory");
            EO_STORE(xa, g);
            if (g + 2 < 8) EO_LOAD(xa, g + 2);
            asm volatile("" ::: "memory");
            EO_STORE(xb, g + 1);
        }
#undef EO_LOAD
#undef EO_STORE
    }
};
typedef float f32x2_t __attribute__((ext_vector_type(2)));
__device__ __forceinline__ f32x4 load_sc1_x4(const float* p) { f32x4 v; asm volatile("global_load_dwordx4 %0, %1, off sc1\n\ts_waitcnt vmcnt(0)" : "=&v"(v) : "v"(p) : "memory"); return v; }
__device__ __forceinline__ f32x2_t load_sc1_x2(const float* p) { f32x2_t v; asm volatile("global_load_dwordx2 %0, %1, off sc1\n\ts_waitcnt vmcnt(0)" : "=&v"(v) : "v"(p) : "memory"); return v; }
struct EpiOutNorm {
    static constexpr bool PERM = true;
    const float* __restrict__ x; bf16_t* __restrict__ x1; const float* __restrict__ ada; const float* __restrict__ g2;
    bf16_t* __restrict__ h2; unsigned char* __restrict__ h28; float* xb; unsigned* cnt; LAS unsigned char* lx;
    __device__ __forceinline__ void operator()(Acc& acc, const Unit& u, int wr, int wc, int fr, int fq) const {
        const int row0 = u.pm * BM + wr * 64 + fr, col0 = u.pn * BM + wc * 32 + 8 * fq;
        const float* adab = ada + (size_t)((u.pm * BM) >> 13) * 6144;
        float ps[8];
        {
            f32x4 gv[2][2];
#pragma unroll
            for (int bj = 0; bj < 2; ++bj)
#pragma unroll
                for (int n = 0; n < 2; ++n) gv[bj][n] = *(const f32x4*)(adab + 2048 + col0 + bj * HALF + n * 4);
            f32x4 xa[2][2], xb2[2][2];
#define EN_LOAD(dst, g) do { const unsigned off_ = (unsigned)((row0 + ((g) >> 2) * HALF + ((g) & 3) * 16) * DM + col0); _Pragma("unroll") for (int bj = 0; bj < 2; ++bj) _Pragma("unroll") for (int n = 0; n < 2; ++n) dst[bj][n] = *(const f32x4*)((const char*)x + (off_ + bj * HALF + n * 4) * 4u); } while (0)
#define EN_STORE(srcv, g) do { const unsigned off_ = (unsigned)((row0 + ((g) >> 2) * HALF + ((g) & 3) * 16) * DM + col0); float s_ = 0.f; _Pragma("unroll") for (int bj = 0; bj < 2; ++bj) { \
                const f32x4 v0 = srcv[bj][0] + gv[bj][0] * acc[(g) >> 2][bj][(g) & 3][0], v1 = srcv[bj][1] + gv[bj][1] * acc[(g) >> 2][bj][(g) & 3][1]; \
                acc[(g) >> 2][bj][(g) & 3][0] = v0; acc[(g) >> 2][bj][(g) & 3][1] = v1; \
                s_ += (v0[0] * v0[0] + v0[1] * v0[1]) + (v0[2] * v0[2] + v0[3] * v0[3]) + (v1[0] * v1[0] + v1[1] * v1[1]) + (v1[2] * v1[2] + v1[3] * v1[3]); \
                u32x4 w; w.x = pk_bf16(v0[0], v0[1]); w.y = pk_bf16(v0[2], v0[3]); w.z = pk_bf16(v1[0], v1[1]); w.w = pk_bf16(v1[2], v1[3]); *(u32x4*)((char*)x1 + (off_ + bj * HALF) * 2u) = w; } ps[g] = s_; } while (0)
            EN_LOAD(xa, 0);
#pragma unroll
            for (int g = 0; g < 8; g += 2) {
                EN_LOAD(xb2, g + 1);
                asm volatile("" ::: "memory");
                EN_STORE(xa, g);
                if (g + 2 < 8) EN_LOAD(xa, g + 2);
                asm volatile("" ::: "memory");
                EN_STORE(xb2, g + 1);
            }
#undef EN_LOAD
#undef EN_STORE
        }
#pragma unroll
        for (int g = 0; g < 8; ++g) { ps[g] += __shfl_xor(ps[g], 16); ps[g] += __shfl_xor(ps[g], 32); }
        LAS float* P = (LAS float*)lx; LAS float* S = P + 1024;
        if (fq == 0) {
#pragma unroll
            for (int g = 0; g < 8; ++g) P[((g >> 2) * HALF + wr * 64 + (g & 3) * 16 + fr) * 4 + wc] = ps[g]; }
        asm volatile("s_waitcnt lgkmcnt(0)" ::: "memory"); __builtin_amdgcn_s_barrier(); asm volatile("" ::: "memory");
        const int w = wr * 4 + wc, lane = fq * 16 + fr, prow = 32 * w + (lane & 31);
        float* slot = xb + ((size_t)(u.e * 128 + u.pm) * 256 + prow) * 4;
        unsigned* c = cnt + (size_t)(u.e * 128 + u.pm) * 64;
        if (lane < 32) { const float t = (P[prow * 4 + 0] + P[prow * 4 + 1]) + (P[prow * 4 + 2] + P[prow * 4 + 3]);
            __hip_atomic_store(slot + u.pn, t, __ATOMIC_RELAXED, __HIP_MEMORY_SCOPE_AGENT); }
        asm volatile("s_waitcnt vmcnt(0)" ::: "memory");
        if (lane == 0) __hip_atomic_fetch_add(c, 1u, __ATOMIC_RELAXED, __HIP_MEMORY_SCOPE_AGENT);
        if (w == 0) {
            unsigned spins = 0;
            while ((unsigned)__builtin_amdgcn_readfirstlane(__hip_atomic_load(c, __ATOMIC_RELAXED, __HIP_MEMORY_SCOPE_AGENT)) < 32u) { __builtin_amdgcn_s_sleep(2); if (++spins > (1u << 22)) break; }
            __builtin_amdgcn_fence(__ATOMIC_ACQUIRE, "agent");
            asm volatile("s_waitcnt vmcnt(0)" ::: "memory");
        }
        asm volatile("s_waitcnt lgkmcnt(0)" ::: "memory"); __builtin_amdgcn_s_barrier(); asm volatile("" ::: "memory");
        if (lane < 32) { const f32x4 s4 = load_sc1_x4(slot); const float t = (s4[0] + s4[1]) + (s4[2] + s4[3]);
            S[prow] = rsqrtf(t * (1.0f / DM) + NORM_EPS); }
        asm volatile("s_waitcnt lgkmcnt(0)" ::: "memory"); __builtin_amdgcn_s_barrier(); asm volatile("" ::: "memory");
#pragma unroll
        for (int bj = 0; bj < 2; ++bj) {
            f32x4 gm[2], sh[2];
#pragma unroll
            for (int n = 0; n < 2; ++n) { const int cc = col0 + bj * HALF + n * 4; gm[n] = *(const f32x4*)(g2 + cc) * (*(const f32x4*)(adab + 4096 + cc) + 1.0f); sh[n] = *(const f32x4*)(adab + 3072 + cc); }
#pragma unroll
            for (int g = 0; g < 8; ++g) { const int rl = (g >> 2) * HALF + wr * 64 + (g & 3) * 16 + fr; const float rs = S[rl];
                const f32x4 y0 = acc[g >> 2][bj][g & 3][0] * rs * gm[0] + sh[0], y1 = acc[g >> 2][bj][g & 3][1] * rs * gm[1] + sh[1];
                const unsigned off_ = (unsigned)((u.pm * BM + rl) * DM + col0 + bj * HALF);
                u32x4 wv; wv.x = pk_bf16(y0[0], y0[1]); wv.y = pk_bf16(y0[2], y0[3]); wv.z = pk_bf16(y1[0], y1[1]); wv.w = pk_bf16(y1[2], y1[3]);
                *(u32x4*)((char*)h2 + off_ * 2u) = wv;
                u32x2 w8; w8.x = pk4_fp8(y0[0], y0[1], y0[2], y0[3]); w8.y = pk4_fp8(y1[0], y1[1], y1[2], y1[3]);
                *(u32x2*)(h28 + off_) = w8; }
        }
    }
};
struct EpiPw2Norm {
    static constexpr bool PERM = true;
    const float* __restrict__ bias; const float* __restrict__ gc; bf16_t* __restrict__ mix; float* xb; unsigned* cnt; LAS unsigned char* lx;
    __device__ __forceinline__ void operator()(Acc& acc, const Unit& u, int wr, int wc, int fr, int fq) const {
        const int col0 = u.pn * BM + wc * 32 + 8 * fq;
        float ps[8];
        {
            f32x4 bv[2][2];
#pragma unroll
            for (int bj = 0; bj < 2; ++bj)
#pragma unroll
                for (int n = 0; n < 2; ++n) bv[bj][n] = *(const f32x4*)(bias + col0 + bj * HALF + 4 * n);
#pragma unroll
            for (int g = 0; g < 8; ++g) { float s_ = 0.f;
#pragma unroll
                for (int bj = 0; bj < 2; ++bj)
#pragma unroll
                    for (int n = 0; n < 2; ++n) { const f32x4 v = acc[g >> 2][bj][g & 3][n] + bv[bj][n]; acc[g >> 2][bj][g & 3][n] = v; s_ += (v[0] * v[0] + v[1] * v[1]) + (v[2] * v[2] + v[3] * v[3]); }
                ps[g] = s_; }
        }
#pragma unroll
        for (int g = 0; g < 8; ++g) { ps[g] += __shfl_xor(ps[g], 16); ps[g] += __shfl_xor(ps[g], 32); }
        LAS float* P = (LAS float*)lx; LAS float* S = P + 1024;
        if (fq == 0) {
#pragma unroll
            for (int g = 0; g < 8; ++g) P[((g >> 2) * HALF + wr * 64 + (g & 3) * 16 + fr) * 4 + wc] = ps[g]; }
        asm volatile("s_waitcnt lgkmcnt(0)" ::: "memory"); __builtin_amdgcn_s_barrier(); asm volatile("" ::: "memory");
        const int w = wr * 4 + wc, lane = fq * 16 + fr, prow = 32 * w + (lane & 31);
        float* slot = xb + ((size_t)u.pm * 256 + prow) * 2;
        unsigned* c = cnt + (size_t)u.pm * 64;
        if (lane < 32) { const float t = (P[prow * 4 + 0] + P[prow * 4 + 1]) + (P[prow * 4 + 2] + P[prow * 4 + 3]);
            __hip_atomic_store(slot + u.pn, t, __ATOMIC_RELAXED, __HIP_MEMORY_SCOPE_AGENT); }
        asm volatile("s_waitcnt vmcnt(0)" ::: "memory");
        if (lane == 0) __hip_atomic_fetch_add(c, 1u, __ATOMIC_RELAXED, __HIP_MEMORY_SCOPE_AGENT);
        if (w == 0) {
            unsigned spins = 0;
            while ((unsigned)__builtin_amdgcn_readfirstlane(__hip_atomic_load(c, __ATOMIC_RELAXED, __HIP_MEMORY_SCOPE_AGENT)) < 16u) { __builtin_amdgcn_s_sleep(2); if (++spins > (1u << 22)) break; }
            __builtin_amdgcn_fence(__ATOMIC_ACQUIRE, "agent");
            asm volatile("s_waitcnt vmcnt(0)" ::: "memory");
        }
        asm volatile("s_waitcnt lgkmcnt(0)" ::: "memory"); __builtin_amdgcn_s_barrier(); asm volatile("" ::: "memory");
        if (lane < 32) { const f32x2_t s2 = load_sc1_x2(slot); const float t = s2[0] + s2[1];
            S[prow] = rsqrtf(t * (1.0f / CW) + NORM_EPS); }
        asm volatile("s_waitcnt lgkmcnt(0)" ::: "memory"); __builtin_amdgcn_s_barrier(); asm volatile("" ::: "memory");
#pragma unroll
        for (int bj = 0; bj < 2; ++bj) {
            f32x4 gm[2];
#pragma unroll
            for (int n = 0; n < 2; ++n) gm[n] = *(const f32x4*)(gc + col0 + bj * HALF + n * 4);
#pragma unroll
            for (int g = 0; g < 8; ++g) { const int rl = (g >> 2) * HALF + wr * 64 + (g & 3) * 16 + fr; const float rs = S[rl];
                const f32x4 y0 = acc[g >> 2][bj][g & 3][0] * rs * gm[0], y1 = acc[g >> 2][bj][g & 3][1] * rs * gm[1];
                u32x4 wv; wv.x = pk_bf16(y0[0], y0[1]); wv.y = pk_bf16(y0[2], y0[3]); wv.z = pk_bf16(y1[0], y1[1]); wv.w = pk_bf16(y1[2], y1[3]);
                *(u32x4*)((char*)mix + (unsigned)(((u.pm * BM + rl) * DM + AW + col0 + bj * HALF) * 2)) = wv; }
        }
    }
};
struct EpiGU {
    static constexpr bool PERM = true;
    unsigned char* H;
    __device__ __forceinline__ void operator()(const Acc& acc, const Unit& u, int wr, int wc, int fr, int fq) const {
        const int row0 = u.pm + wr * 64 + fr, col0 = u.pn * 128 + wc * 32 + 8 * fq;
#pragma unroll
        for (int ai = 0; ai < 2; ++ai)
#pragma unroll
            for (int m = 0; m < 4; ++m) {
                float v[8];
#pragma unroll
                for (int j = 0; j < 4; ++j) { v[j] = silu_fast(acc[ai][0][m][0][j] * F8_WINV) * (acc[ai][1][m][0][j] * F8_WINV); v[4 + j] = silu_fast(acc[ai][0][m][1][j] * F8_WINV) * (acc[ai][1][m][1][j] * F8_WINV); }
                u32x2 w; w.x = pk4_fp8(v[0], v[1], v[2], v[3]); w.y = pk4_fp8(v[4], v[5], v[6], v[7]);
                *(u32x2*)(H + (size_t)(row0 + ai * HALF + m * 16) * FE + col0) = w;
            }
    }
};
struct EpiDown {
    static constexpr bool PERM = true;
    static constexpr bool PF = true;
    unsigned char* Y; LAS unsigned char* xch; const int* aids;
    __device__ __forceinline__ void pf_issue(int upm, int ukind, int par, int wr, int wc) const {
        int tz = threadIdx.x; asm volatile("" : "+v"(tz)); const int lane = tz & 63;
        const int row = upm + (wc & 1) * HALF + wr * 64 + lane;
        __builtin_amdgcn_global_load_lds((const unsigned*)(aids + (ukind == 0 ? row : lane)), (LAS unsigned*)(xch + 4 * 4352 + par * 1024 + wr * 512 + (wc & 1) * 256), 4, 0, 0);
    }
    __device__ __forceinline__ void operator()(const Acc& acc, const Unit& u, int wr, int wc, int fr, int fq, int par) const {
        const float sc = 16.0f * F8_WINV;
        const int lt = threadIdx.x & 255, rrow = lt >> 4, rc16 = lt & 15;
        const int wbyte = fr * 272 + wc * 32 + 8 * fq;
        static_assert((WS_H2F8 - WS_YBUF) % 1024 == 0, "dummy rows must be row-aligned");
        constexpr int DR0 = (int)((WS_H2F8 - WS_YBUF) / 1024);
        const LAS int* ib = (const LAS int*)(xch + 4 * 4352 + par * 1024 + wr * 512);
        const bool k0 = u.kind == 0;
        unsigned char* gbase = Y + u.pn * BM + 16 * rc16;
#pragma unroll
        for (int g = 0; g < 8; ++g) {
            const int ai = g >> 2, m = g & 3;
            LAS unsigned char* buf = xch + (wr * 2 + (g & 1)) * 4352;
#pragma unroll
            for (int bj = 0; bj < 2; ++bj) { const f32x4 v0 = acc[ai][bj][m][0] * sc, v1 = acc[ai][bj][m][1] * sc;
                u32x2 w; w.x = pk4_fp8(v0[0], v0[1], v0[2], v0[3]); w.y = pk4_fp8(v1[0], v1[1], v1[2], v1[3]);
                *(LAS u32x2*)(buf + wbyte + bj * HALF) = w; }
            const int aid = ib[ai * 64 + m * 16 + rrow], slot = u.pm + ai * HALF + wr * 64 + m * 16 + rrow;
            asm volatile("s_waitcnt lgkmcnt(0)" ::: "memory"); __builtin_amdgcn_s_barrier(); asm volatile("" ::: "memory");
            const u32x4 o = *(const LAS u32x4*)(buf + rrow * 272 + 16 * rc16);
            const int ya = aid < 0 ? DR0 + (slot & (NT - 1)) : aid + (aid >> 3), yb = (slot - NSLOT_MAX) * 9 + 8;
            *(u32x4*)(gbase + (size_t)(k0 ? ya : yb) * DM) = o;
        }
    }
};

struct Args {
    const float* in[26];
    float* out;
    unsigned char* ws;
    int ph_lo, ph_hi;
};
constexpr int NPHASE = 14;

__device__ __forceinline__ void transpose_job(LAS unsigned* T, const float* srcA, const float* srcB, int ldsrc, bf16_t* dst, int lddst) {
    const int tid = threadIdx.x, lane = tid & 63, w = tid >> 6;
    const float* src = (lane < 32) ? (srcA + 4 * lane) : (srcB + 4 * (lane - 32));
    f32x4 v0[4], v1[4];
#pragma unroll
    for (int i = 0; i < 4; ++i) { const int k0 = 2 * w + 16 * i; v0[i] = *(const f32x4*)(src + (size_t)k0 * ldsrc); v1[i] = *(const f32x4*)(src + (size_t)(k0 + 1) * ldsrc); }
#pragma unroll
    for (int i = 0; i < 4; ++i)
#pragma unroll
        for (int j = 0; j < 4; ++j) T[(j * 64 + lane) * 33 + (w + 8 * i)] = pk_bf16(v0[i][j], v1[i][j]);
    __syncthreads();
#pragma unroll
    for (int q = 0; q < 4; ++q) { const int n = (tid >> 3) + 64 * q, kc = tid & 7, rho = (n & 3) * 64 + (n >> 2);
        u32x4 o; o.x = T[rho * 33 + kc * 4 + 0]; o.y = T[rho * 33 + kc * 4 + 1]; o.z = T[rho * 33 + kc * 4 + 2]; o.w = T[rho * 33 + kc * 4 + 3];
        *(u32x4*)(dst + (size_t)n * lddst + kc * 8) = o; }
    __syncthreads();
}
struct F8Job { const float* a; const float* b; int ld; unsigned char* dst; int ldd; };
__device__ __forceinline__ void f8job_load(const F8Job& J, f32x4 (&v)[4][4]) {
    const int lane = threadIdx.x & 63, w = threadIdx.x >> 6;
    const float* src = (lane < 32) ? (J.a + 4 * lane) : (J.b + 4 * (lane - 32));
#pragma unroll
    for (int i = 0; i < 4; ++i)
#pragma unroll
        for (int kk = 0; kk < 4; ++kk) v[i][kk] = *(const f32x4*)(src + (size_t)(4 * w + 32 * i + kk) * J.ld);
}
__device__ __forceinline__ void f8job_park(LAS unsigned* T, const f32x4 (&v)[4][4], float sc) {
    const int lane = threadIdx.x & 63, w = threadIdx.x >> 6;
#pragma unroll
    for (int i = 0; i < 4; ++i)
#pragma unroll
        for (int j = 0; j < 4; ++j) T[(j * 64 + lane) * 33 + (w + 8 * i)] = pk4_fp8(v[i][0][j] * sc, v[i][1][j] * sc, v[i][2][j] * sc, v[i][3][j] * sc);
}
__device__ __forceinline__ void f8job_store(const LAS unsigned* T, const F8Job& J) {
    const int tid = threadIdx.x;
#pragma unroll
    for (int q = 0; q < 4; ++q) { const int n = (tid >> 3) + 64 * q, kc = tid & 7, rho = (n & 3) * 64 + (n >> 2);
        u32x4 o; o.x = T[rho * 33 + kc * 4 + 0]; o.y = T[rho * 33 + kc * 4 + 1]; o.z = T[rho * 33 + kc * 4 + 2]; o.w = T[rho * 33 + kc * 4 + 3];
        *(u32x4*)(J.dst + (size_t)n * J.ldd + kc * 16) = o; }
}
constexpr int JOBS_GU = 257 * 16, JOBS_DN = 257 * 8, JOBS_F8 = JOBS_GU + JOBS_DN, JOBS_IN = 160, JOBS_OUT = 64, JOBS_PW2 = 16, JOBS_R = 16;
constexpr int JOBS_BF = JOBS_IN + JOBS_OUT + JOBS_PW2 + JOBS_R;

__device__ __forceinline__ void convert_f8_jobs(const Args& a, LAS unsigned char* lds, int jlo, int jhi, int k, int nk) {
    unsigned char* ws = a.ws; LAS unsigned* T = (LAS unsigned*)lds;
    const float* wg = a.in[19]; const float* wu = a.in[20]; const float* wd = a.in[21];
    const float* sg = a.in[22]; const float* su = a.in[23]; const float* sd = a.in[24];
    auto decode = [&](int j) -> F8Job { F8Job J;
        if (j < JOBS_GU) { const int e = j >> 4, r = j & 15, h = r >> 3, k0 = (r & 7) * 128;
            const float* ge = (e < NEXP) ? wg + (size_t)e * DM * FE : sg; const float* ue = (e < NEXP) ? wu + (size_t)e * DM * FE : su;
            J.a = ge + (size_t)k0 * FE + 128 * h; J.b = ue + (size_t)k0 * FE + 128 * h; J.ld = FE; J.dst = (unsigned char*)(ws + WS_WGU) + (size_t)(e * 2 + h) * 256 * DM + k0; J.ldd = DM;
        } else { const int jj = j - JOBS_GU, e = jj >> 3, r = jj & 7, n0 = (r >> 1) * 256, k0 = (r & 1) * 128;
            const float* de = (e < NEXP) ? wd + (size_t)e * FE * DM : sd;
            J.a = de + (size_t)k0 * DM + n0; J.b = J.a + 128; J.ld = DM; J.dst = (unsigned char*)(ws + WS_WDT) + ((size_t)e * DM + n0) * FE + k0; J.ldd = FE; }
        return J; };
    if (jlo + k < jhi) {
        f32x4 va[4][4], vb[4][4];
        F8Job ja = decode(jlo + k), jb = ja; f8job_load(ja, va);
        if (jlo + k + nk < jhi) { jb = decode(jlo + k + nk); f8job_load(jb, vb); }
        for (int j = jlo + k; j < jhi; j += 2 * nk) {
            { f8job_park(T, va, F8_WSCALE); const F8Job cur = ja; const int jn = j + 2 * nk; if (jn < jhi) { ja = decode(jn); f8job_load(ja, va); }
              __syncthreads(); f8job_store(T, cur); __syncthreads(); }
            if (j + nk < jhi) { f8job_park(T, vb, F8_WSCALE); const F8Job cur = jb; const int jn = j + 3 * nk; if (jn < jhi) { jb = decode(jn); f8job_load(jb, vb); }
              __syncthreads(); f8job_store(T, cur); __syncthreads(); }
        }
    }
}

__device__ __forceinline__ void p0_prologue(const Args& a, LAS unsigned char* lds) {
    const int tid = threadIdx.x, G = gridDim.x, bx = blockIdx.x;
    unsigned char* ws = a.ws;
    {
        LAS float* sl = (LAS float*)lds;
        LAS float* red = (LAS float*)(lds + 16384);
        const float* c = a.in[1]; const float* w_ada = a.in[4]; const float* b_ada = a.in[5];
        float* ada = (float*)(ws + WS_ADA);
        for (int i = tid; i < NB * DM; i += 512) sl[i] = silu_fast(c[i]);
        __syncthreads();
        for (int ci = bx; ci < 256; ci += G) {
            if (tid < 384) {
                const int q = tid % 6, ks = tid / 6, n = 24 * ci + 4 * q;
                f32x4 ac[4];
#pragma unroll
                for (int b = 0; b < 4; ++b) ac[b] = (f32x4){0.f, 0.f, 0.f, 0.f};
#pragma unroll
                for (int kk = 0; kk < 16; ++kk) { const int k = ks * 16 + kk; const f32x4 w4 = *(const f32x4*)(w_ada + (size_t)k * 6144 + n);
#pragma unroll
                    for (int b = 0; b < 4; ++b) ac[b] += w4 * sl[b * 1024 + k]; }
#pragma unroll
                for (int b = 0; b < 4; ++b)
#pragma unroll
                    for (int j = 0; j < 4; ++j) red[tid * 16 + b * 4 + j] = ac[b][j];
            }
            __syncthreads();
            if (tid < 96) { const int b = tid / 24, col = tid % 24, q = col >> 2, j = col & 3; float s = 0.f;
                for (int ks = 0; ks < 64; ++ks) s += red[(ks * 6 + q) * 16 + b * 4 + j];
                ada[(size_t)b * 6144 + 24 * ci + col] = s + b_ada[24 * ci + col]; }
            __syncthreads();
        }
    }
    {
        const int* pos = (const int*)a.in[2]; float* rope = (float*)(ws + WS_ROPE);
        for (int id = bx * 512 + tid; id < NT * 8; id += G * 512) { const int t = id >> 3, i = id & 7;
            const double invf = i == 0 ? 1.0 : i == 1 ? 0.19392274474868576 : i == 2 ? 0.03760603093086393 : i == 3 ? 0.007292664737217109
                              : i == 4 ? 0.001414213562373095 : i == 5 ? 0.0002742481756762073 : i == 6 ? 5.318295896944988e-05 : 1.031338537721246e-05;
            const double rev = (double)pos[t] * invf * 0.15915494309189535; const float fr = (float)(rev - __builtin_rint(rev));
            rope[(size_t)t * 16 + i] = __builtin_amdgcn_cosf(fr); rope[(size_t)t * 16 + 8 + i] = __builtin_amdgcn_sinf(fr); }
    }
    {
        LAS unsigned* T = (LAS unsigned*)lds;
        const float* w_in = a.in[6]; const float* w_pw2 = a.in[11]; const float* w_out = a.in[15]; const float* w_r = a.in[17];
        const float* wg = a.in[19]; const float* wu = a.in[20]; const float* wd = a.in[21];
        const float* sg = a.in[22]; const float* su = a.in[23]; const float* sd = a.in[24];
        for (int j = bx; j < JOBS_BF; j += G) {
            const float* sA; const float* sB; int ld; bf16_t* dst; int ldd;
            if (j < JOBS_IN) { const int pn = j >> 4, k0 = (j & 15) * 64;
                if (pn < 6) { sA = w_in + (size_t)k0 * NPROJ + 256 * pn; sB = sA + 128; }
                else { sA = w_in + (size_t)k0 * NPROJ + 1536 + 128 * (pn - 6); sB = w_in + (size_t)k0 * NPROJ + 2048 + 128 * (pn - 6); }
                ld = NPROJ; dst = (bf16_t*)(ws + WS_WIN) + (size_t)pn * 256 * DM + k0; ldd = DM;
            } else if (j < JOBS_IN + JOBS_OUT) { const int jj = j - JOBS_IN, pn = jj >> 4, k0 = (jj & 15) * 64;
                sA = w_out + (size_t)k0 * DM + 256 * pn; sB = sA + 128; ld = DM; dst = (bf16_t*)(ws + WS_WOUT) + (size_t)pn * 256 * DM + k0; ldd = DM;
            } else if (j < JOBS_IN + JOBS_OUT + JOBS_PW2) { const int jj = j - JOBS_IN - JOBS_OUT, pn = jj >> 3, k0 = (jj & 7) * 64;
                sA = w_pw2 + (size_t)k0 * CW + 256 * pn; sB = sA + 128; ld = CW; dst = (bf16_t*)(ws + WS_WPW2) + (size_t)pn * 256 * CW + k0; ldd = CW;
            } else { const int jj = j - JOBS_IN - JOBS_OUT - JOBS_PW2, k0 = jj * 64;
                sA = w_r + (size_t)k0 * NEXP; sB = sA + 128; ld = NEXP; dst = (bf16_t*)(ws + WS_WR) + k0; ldd = DM; }
            transpose_job(T, sA, sB, ld, dst, ldd);
        }
        if (G != 256) convert_f8_jobs(a, lds, 0, JOBS_F8, bx, G);
    }
}

__device__ __forceinline__ void normmod_phase(const float* X, const float* g, const float* sh, const float* sc, bf16_t* H) {
    const int lane = threadIdx.x & 63, wave = threadIdx.x >> 6;
    for (int row = blockIdx.x * 8 + wave; row < NT; row += gridDim.x * 8) {
        const int b = row >> 13;
        f32x4 xv[4]; float ss = 0.f;
#pragma unroll
        for (int j = 0; j < 4; ++j) { xv[j] = *(const f32x4*)(X + (size_t)row * DM + 4 * lane + 256 * j); ss += xv[j][0] * xv[j][0] + xv[j][1] * xv[j][1] + xv[j][2] * xv[j][2] + xv[j][3] * xv[j][3]; }
        ss = wave_sum(ss);
        const float rstd = rsqrtf(ss * (1.0f / DM) + NORM_EPS);
#pragma unroll
        for (int j = 0; j < 4; ++j) { const int col = 4 * lane + 256 * j;
            const f32x4 gv = *(const f32x4*)(g + col), sv = *(const f32x4*)(sc + (size_t)b * 6144 + col), hv = *(const f32x4*)(sh + (size_t)b * 6144 + col);
            const f32x4 y = (xv[j] * rstd) * gv * (sv + 1.0f) + hv;
            u32x2 w; w.x = pk_bf16(y[0], y[1]); w.y = pk_bf16(y[2], y[3]);
            *(u32x2*)(H + (size_t)row * DM + col) = w; }
    }
}

__device__ __forceinline__ void normmod_bf16_phase(const bf16_t* X, const float* g, const float* sh, const float* sc, bf16_t* H, unsigned char* H8) {
    const int lane = threadIdx.x & 63, wave = threadIdx.x >> 6;
    for (int row = blockIdx.x * 8 + wave; row < NT; row += gridDim.x * 8) {
        const int b = row >> 13;
        float v[2][8]; float ss = 0.f;
#pragma unroll
        for (int j = 0; j < 2; ++j) { const u32x4 w = *(const u32x4*)(X + (size_t)row * DM + 8 * lane + 512 * j);
            v[j][0] = bf_lo(w.x); v[j][1] = bf_hi(w.x); v[j][2] = bf_lo(w.y); v[j][3] = bf_hi(w.y); v[j][4] = bf_lo(w.z); v[j][5] = bf_hi(w.z); v[j][6] = bf_lo(w.w); v[j][7] = bf_hi(w.w);
#pragma unroll
            for (int i = 0; i < 8; ++i) ss += v[j][i] * v[j][i]; }
        ss = wave_sum(ss);
        const float rstd = rsqrtf(ss * (1.0f / DM) + NORM_EPS);
#pragma unroll
        for (int j = 0; j < 2; ++j) { const int col = 8 * lane + 512 * j; float y[8];
#pragma unroll
            for (int q = 0; q < 2; ++q) { const f32x4 gv = *(const f32x4*)(g + col + 4 * q), sv = *(const f32x4*)(sc + (size_t)b * 6144 + col + 4 * q), hv = *(const f32x4*)(sh + (size_t)b * 6144 + col + 4 * q);
#pragma unroll
                for (int i = 0; i < 4; ++i) y[4 * q + i] = (v[j][4 * q + i] * rstd) * gv[i] * (sv[i] + 1.0f) + hv[i]; }
            u32x4 w; w.x = pk_bf16(y[0], y[1]); w.y = pk_bf16(y[2], y[3]); w.z = pk_bf16(y[4], y[5]); w.w = pk_bf16(y[6], y[7]);
            *(u32x4*)(H + (size_t)row * DM + col) = w;
            u32x2 w8; w8.x = pk4_fp8(y[0], y[1], y[2], y[3]); w8.y = pk4_fp8(y[4], y[5], y[6], y[7]);
            *(u32x2*)(H8 + (size_t)row * DM + col) = w8; }
    }
}

__device__ __forceinline__ void attn_naive_unit(int unit, const bf16_t* Q, const bf16_t* Kb, const bf16_t* Vb, bf16_t* O, float* LSE) {
    const int lane = threadIdx.x & 63, head = threadIdx.x >> 6;
    const int t = unit * 64 + lane, b = t >> 13, s = t & (SEQ - 1);
    const size_t hb = (size_t)(b * NHEAD + head) * SEQ;
    float q[64];
    { const u32x4* qp = (const u32x4*)(Q + (hb + s) * HD);
#pragma unroll
      for (int c = 0; c < 8; ++c) { const u32x4 w = qp[c]; q[8 * c + 0] = bf_lo(w.x); q[8 * c + 1] = bf_hi(w.x); q[8 * c + 2] = bf_lo(w.y); q[8 * c + 3] = bf_hi(w.y); q[8 * c + 4] = bf_lo(w.z); q[8 * c + 5] = bf_hi(w.z); q[8 * c + 6] = bf_lo(w.w); q[8 * c + 7] = bf_hi(w.w); } }
    for (int br = 0; br < 3; ++br) {
        const int d = (br == 0) ? 1 : (br == 1 ? 4 : 16);
        float mx = -1e30f, l = 0.f; float o[64];
#pragma unroll
        for (int i = 0; i < 64; ++i) o[i] = 0.f;
        for (int j = 0; j <= 128; ++j) {
            const int p = s - j * d; if (p < 0) break;
            const u32x4* kp = (const u32x4*)(Kb + (hb + p) * HD);
            float sc = 0.f;
#pragma unroll
            for (int c = 0; c < 8; ++c) { const u32x4 w = kp[c];
                sc += q[8 * c + 0] * bf_lo(w.x) + q[8 * c + 1] * bf_hi(w.x) + q[8 * c + 2] * bf_lo(w.y) + q[8 * c + 3] * bf_hi(w.y) + q[8 * c + 4] * bf_lo(w.z) + q[8 * c + 5] * bf_hi(w.z) + q[8 * c + 6] * bf_lo(w.w) + q[8 * c + 7] * bf_hi(w.w); }
            const float mn = fmaxf(mx, sc), al = __expf(mx - mn), pe = __expf(sc - mn);
            l = l * al + pe; mx = mn;
            const u32x4* vp = (const u32x4*)(Vb + (hb + p) * HD);
#pragma unroll
            for (int c = 0; c < 8; ++c) { const u32x4 w = vp[c];
                o[8 * c + 0] = o[8 * c + 0] * al + pe * bf_lo(w.x); o[8 * c + 1] = o[8 * c + 1] * al + pe * bf_hi(w.x);
                o[8 * c + 2] = o[8 * c + 2] * al + pe * bf_lo(w.y); o[8 * c + 3] = o[8 * c + 3] * al + pe * bf_hi(w.y);
                o[8 * c + 4] = o[8 * c + 4] * al + pe * bf_lo(w.z); o[8 * c + 5] = o[8 * c + 5] * al + pe * bf_hi(w.z);
                o[8 * c + 6] = o[8 * c + 6] * al + pe * bf_lo(w.w); o[8 * c + 7] = o[8 * c + 7] * al + pe * bf_hi(w.w); }
        }
        const float inv = 1.0f / l;
        u32x4* op = (u32x4*)(O + ((size_t)br * NT + t) * AW + head * HD);
#pragma unroll
        for (int c = 0; c < 8; ++c) { u32x4 w; w.x = pk_bf16(o[8 * c + 0] * inv, o[8 * c + 1] * inv); w.y = pk_bf16(o[8 * c + 2] * inv, o[8 * c + 3] * inv); w.z = pk_bf16(o[8 * c + 4] * inv, o[8 * c + 5] * inv); w.w = pk_bf16(o[8 * c + 6] * inv, o[8 * c + 7] * inv); op[c] = w; }
        LSE[((size_t)br * NT + t) * NHEAD + head] = mx + __logf(l);
    }
}


typedef float f32x16 __attribute__((ext_vector_type(16)));
typedef short v4i16_t __attribute__((ext_vector_type(4)));
template <int AM = 0>
__device__ __forceinline__ void attn_unit(int unit, LAS unsigned char* lds, const bf16_t* Q, const bf16_t* Kb, const bf16_t* Vb, bf16_t* O, float* LSE) {
    const int tid = threadIdx.x, lane = tid & 63, w = __builtin_amdgcn_readfirstlane(tid >> 6), r32 = lane & 31, hi = lane >> 5;
    const int blk = unit & 31, rest = unit >> 5, br = rest % 3, bh = rest / 3;
    const int dsh = 2 * br, nper = 32 >> dsh, res = blk / nper, mblk = blk & (nper - 1), m0 = mblk * 256;
    const size_t hb = (size_t)bh * SEQ;
    u32x4 vst[6];
#pragma unroll
    for (int it = 0; it < 6; ++it) { const int cidx = tid + 512 * it, row = cidx >> 3, c = cidx & 7; int kidx = m0 - 128 + row; kidx = kidx < 0 ? 0 : kidx;
        vst[it] = *(const u32x4*)(Vb + (hb + ((size_t)kidx << dsh) + res) * HD + 8 * c); }
    const int qm = m0 + 32 * w + r32; const size_t qpos = ((size_t)qm << dsh) + res;
    bf16x8 qf[4];
#pragma unroll
    for (int s = 0; s < 4; ++s) qf[s] = *(const bf16x8*)(Q + (hb + qpos) * HD + 16 * s + 8 * hi);
    {
        u32x4 kst[6];
#pragma unroll
        for (int it = 0; it < 6; ++it) { const int cidx = tid + 512 * it, row = cidx >> 3, c = cidx & 7; int kidx = m0 - 128 + row; kidx = kidx < 0 ? 0 : kidx;
            kst[it] = *(const u32x4*)(Kb + (hb + ((size_t)kidx << dsh) + res) * HD + 8 * c); }
#pragma unroll
        for (int it = 0; it < 6; ++it) { const int cidx = tid + 512 * it, row = cidx >> 3, c = cidx & 7;
            *(LAS u32x4*)(lds + 49152 + row * 128 + 16 * (c ^ ((row >> 1) & 7))) = kst[it]; }
#pragma unroll
        for (int it = 0; it < 6; ++it) { const int cidx = tid + 512 * it, row = cidx >> 3, c = cidx & 7;
            *(LAS u32x4*)(lds + row * 128 + ((16 * c) ^ (((row >> 1) & 1) << 6))) = vst[it]; }
    }
    __syncthreads();
    f32x16 S[5];
    const int kswz = (r32 >> 1) & 7;
#pragma unroll
    for (int i = 0; i < 5; ++i) {
        const LAS unsigned char* kr = lds + 49152 + (32 * w + 32 * i + r32) * 128;
        bf16x8 kf[4];
#pragma unroll
        for (int s = 0; s < 4; ++s) kf[s] = *(const LAS bf16x8*)(kr + 16 * ((2 * s + hi) ^ kswz));
        f32x16 c = {0.f, 0.f, 0.f, 0.f, 0.f, 0.f, 0.f, 0.f, 0.f, 0.f, 0.f, 0.f, 0.f, 0.f, 0.f, 0.f};
#pragma unroll
        for (int s = 0; s < 4; ++s) c = __builtin_amdgcn_mfma_f32_32x32x16_bf16(kf[s], qf[s], c, 0, 0, 0);
        S[i] = c;
    }
    if constexpr (AM == 1) { _Pragma("unroll") for (int i = 0; i < 5; ++i) asm volatile("" :: "v"(S[i])); __syncthreads(); return; }
    float mx = -3e38f;
#pragma unroll
    for (int i = 0; i < 5; ++i) {
        const bool tile_ok = (mblk > 0) || (w + i >= 4);
#pragma unroll
        for (int r = 0; r < 16; ++r) { const int kl = (r & 3) + 8 * (r >> 2) + 4 * hi;
            bool ok = tile_ok; if (i == 0) ok = ok && (kl >= r32); if (i == 4) ok = ok && (kl <= r32);
            const float v = ok ? S[i][r] : -3e38f; S[i][r] = v; mx = fmaxf(mx, v); }
    }
    mx = fmaxf(mx, __shfl_xor(mx, 32));
    const float nm = -mx * 1.4426950408889634f;
    float l = 0.f;
#pragma unroll
    for (int i = 0; i < 5; ++i)
#pragma unroll
        for (int r = 0; r < 16; ++r) { const float p = __builtin_amdgcn_exp2f(__builtin_fmaf(S[i][r], 1.4426950408889634f, nm)); S[i][r] = p; l += p; }
    l += __shfl_xor(l, 32);
    if constexpr (AM == 2) { _Pragma("unroll") for (int i = 0; i < 5; ++i) asm volatile("" :: "v"(S[i])); asm volatile("" :: "v"(l), "v"(mx)); __syncthreads(); return; }
    f32x16 o0 = {0.f, 0.f, 0.f, 0.f, 0.f, 0.f, 0.f, 0.f, 0.f, 0.f, 0.f, 0.f, 0.f, 0.f, 0.f, 0.f}, o1 = o0;
    const int qq = (lane & 15) >> 2, pp = lane & 3, g1 = (lane >> 4) & 1;
    const int vb0 = (4 * hi + qq) * 128 + ((32 * g1 + 8 * pp) ^ (((qq >> 1) & 1) << 6)), vb1 = vb0 ^ 64;
#pragma unroll
    for (int i = 0; i < 5; ++i)
#pragma unroll
        for (int s2 = 0; s2 < 2; ++s2) {
            u32x4 pw; pw.x = pk_bf16(S[i][8 * s2 + 0], S[i][8 * s2 + 1]); pw.y = pk_bf16(S[i][8 * s2 + 2], S[i][8 * s2 + 3]); pw.z = pk_bf16(S[i][8 * s2 + 4], S[i][8 * s2 + 5]); pw.w = pk_bf16(S[i][8 * s2 + 6], S[i][8 * s2 + 7]);
            const bf16x8 pf = __builtin_bit_cast(bf16x8, pw);
            const int rowoff = (32 * w + 32 * i + 16 * s2) * 128;
            const v4i16_t a0 = __builtin_amdgcn_ds_read_tr16_b64_v4i16((LAS v4i16_t*)(lds + vb0 + rowoff)), a1 = __builtin_amdgcn_ds_read_tr16_b64_v4i16((LAS v4i16_t*)(lds + vb0 + rowoff + 1024));
            const v4i16_t b0 = __builtin_amdgcn_ds_read_tr16_b64_v4i16((LAS v4i16_t*)(lds + vb1 + rowoff)), b1 = __builtin_amdgcn_ds_read_tr16_b64_v4i16((LAS v4i16_t*)(lds + vb1 + rowoff + 1024));
            const bf16x8 vf0 = (bf16x8){a0[0], a0[1], a0[2], a0[3], a1[0], a1[1], a1[2], a1[3]}, vf1 = (bf16x8){b0[0], b0[1], b0[2], b0[3], b1[0], b1[1], b1[2], b1[3]};
            o0 = __builtin_amdgcn_mfma_f32_32x32x16_bf16(vf0, pf, o0, 0, 0, 0);
            o1 = __builtin_amdgcn_mfma_f32_32x32x16_bf16(vf1, pf, o1, 0, 0, 0);
        }
    if constexpr (AM == 3) { asm volatile("" :: "v"(o0), "v"(o1), "v"(l), "v"(mx)); __syncthreads(); return; }
    const float inv = 1.0f / l;
    const int head = bh & 7, b = bh >> 3; const size_t t = (size_t)b * SEQ + qpos;
    {
        LAS unsigned char* stg = lds + 98304 + w * 4352;
#pragma unroll
        for (int g = 0; g < 4; ++g) {
            u32x2 w0; w0.x = pk_bf16(o0[4 * g + 0] * inv, o0[4 * g + 1] * inv); w0.y = pk_bf16(o0[4 * g + 2] * inv, o0[4 * g + 3] * inv); *(LAS u32x2*)(stg + r32 * 136 + 2 * (8 * g + 4 * hi)) = w0;
            u32x2 w1; w1.x = pk_bf16(o1[4 * g + 0] * inv, o1[4 * g + 1] * inv); w1.y = pk_bf16(o1[4 * g + 2] * inv, o1[4 * g + 3] * inv); *(LAS u32x2*)(stg + r32 * 136 + 2 * (32 + 8 * g + 4 * hi)) = w1;
        }
        asm volatile("s_waitcnt lgkmcnt(0)" ::: "memory");
        const size_t tq0 = (size_t)b * SEQ + (((size_t)(m0 + 32 * w) << dsh) + res);
#pragma unroll
        for (int i = 0; i < 4; ++i) { const int rq = i * 8 + (lane >> 3), ch = lane & 7;
            const u32x2 lo = *(const LAS u32x2*)(stg + rq * 136 + 16 * ch), hi2 = *(const LAS u32x2*)(stg + rq * 136 + 16 * ch + 8);
            u32x4 ov; ov.x = lo.x; ov.y = lo.y; ov.z = hi2.x; ov.w = hi2.y;
            *(u32x4*)(O + ((size_t)br * NT + tq0 + ((size_t)rq << dsh)) * AW + head * HD + 8 * ch) = ov; }
    }
    if (hi == 0) LSE[((size_t)br * NT + t) * NHEAD + head] = mx + __logf(l);
    __syncthreads();
}

__device__ __forceinline__ void conv_unit(int unit, LAS unsigned char* lds, const bf16_t* Ab, const float* w_dw, const float* b_dw, const float* ln_g, const float* ln_b, bf16_t* Z) {
    const int tid = threadIdx.x, lane = tid & 63, wave = tid >> 6;
    const int t0 = unit * 32, s0 = t0 & (SEQ - 1);
    LAS float* Y = (LAS float*)lds;
    {
        const int c = tid;
        float wv[CONVK];
#pragma unroll
        for (int j = 0; j < CONVK; ++j) wv[j] = w_dw[j * CW + c];
        LAS unsigned char* Aw = lds + 65536;
        for (int r = wave; r < 62; r += 8) { const int s = s0 - 30 + r; const int tt = (s >= 0) ? (t0 - 30 + r) : (t0 - s0);
            __builtin_amdgcn_global_load_lds((const unsigned*)((const char*)Ab + (size_t)tt * (CW * 2) + lane * 16), (LAS unsigned*)(Aw + r * 1024), 16, 0, 0); }
        asm volatile("s_waitcnt vmcnt(0)" ::: "memory");
        __syncthreads();
        float av[62];
#pragma unroll
        for (int i = 0; i < 62; ++i) { const int s = s0 - 30 + i; const float ld = __uint_as_float((unsigned)(*(const LAS unsigned short*)(Aw + i * 1024 + c * 2)) << 16); av[i] = (s >= 0) ? ld : 0.f; }
        const float bd = b_dw[c];
#pragma unroll
        for (int i = 0; i < 32; ++i) { float y = bd;
#pragma unroll
            for (int j = 0; j < CONVK; ++j) y += wv[j] * av[i + j];
            Y[i * CW + c] = y; }
    }
    __syncthreads();
#pragma unroll
    for (int r = 0; r < 4; ++r) {
        const int i = wave * 4 + r;
        const f32x4 y0 = *(const LAS f32x4*)(Y + i * CW + 8 * lane), y1 = *(const LAS f32x4*)(Y + i * CW + 8 * lane + 4);
        float sm = (y0[0] + y0[1]) + (y0[2] + y0[3]) + (y1[0] + y1[1]) + (y1[2] + y1[3]);
        sm = wave_sum(sm);
        const float mu = sm * (1.0f / CW);
        const f32x4 d0 = y0 - mu, d1 = y1 - mu;
        float vq = (d0[0] * d0[0] + d0[1] * d0[1]) + (d0[2] * d0[2] + d0[3] * d0[3]) + (d1[0] * d1[0] + d1[1] * d1[1]) + (d1[2] * d1[2] + d1[3] * d1[3]);
        vq = wave_sum(vq);
        const float rstd = rsqrtf(vq * (1.0f / CW) + NORM_EPS);
        const f32x4 g0 = *(const f32x4*)(ln_g + 8 * lane), g1 = *(const f32x4*)(ln_g + 8 * lane + 4), b0 = *(const f32x4*)(ln_b + 8 * lane), b1 = *(const f32x4*)(ln_b + 8 * lane + 4);
        f32x4 z0 = d0 * rstd * g0 + b0, z1 = d1 * rstd * g1 + b1;
#pragma unroll
        for (int j = 0; j < 4; ++j) { z0[j] = silu_fast(z0[j]); z1[j] = silu_fast(z1[j]); }
        u32x4 w; w.x = pk_bf16(z0[0], z0[1]); w.y = pk_bf16(z0[2], z0[3]); w.z = pk_bf16(z1[0], z1[1]); w.w = pk_bf16(z1[2], z1[3]);
        *(u32x4*)(Z + (size_t)(t0 + i) * CW + 8 * lane) = w;
    }
    __syncthreads();
}

__device__ __forceinline__ void mix_phase(const bf16_t* O, const float* LSE, const bf16_t* CR, const float* g_a, const float* g_c, bf16_t* MIX) {
    const int lane = threadIdx.x & 63, wave = threadIdx.x >> 6, head = lane >> 3;
    for (int t = blockIdx.x * 8 + wave; t < NT; t += gridDim.x * 8) {
        float l0 = LSE[((size_t)0 * NT + t) * NHEAD + head], l1 = LSE[((size_t)1 * NT + t) * NHEAD + head], l2 = LSE[((size_t)2 * NT + t) * NHEAD + head];
        const float mm = fmaxf(l0, fmaxf(l1, l2));
        float w0 = __expf(l0 - mm), w1 = __expf(l1 - mm), w2 = __expf(l2 - mm); const float inv = 1.0f / (w0 + w1 + w2); w0 *= inv; w1 *= inv; w2 *= inv;
        const u32x4 a0 = *(const u32x4*)(O + ((size_t)0 * NT + t) * AW + 8 * lane), a1 = *(const u32x4*)(O + ((size_t)1 * NT + t) * AW + 8 * lane), a2 = *(const u32x4*)(O + ((size_t)2 * NT + t) * AW + 8 * lane);
        float v[8];
        v[0] = w0 * bf_lo(a0.x) + w1 * bf_lo(a1.x) + w2 * bf_lo(a2.x); v[1] = w0 * bf_hi(a0.x) + w1 * bf_hi(a1.x) + w2 * bf_hi(a2.x);
        v[2] = w0 * bf_lo(a0.y) + w1 * bf_lo(a1.y) + w2 * bf_lo(a2.y); v[3] = w0 * bf_hi(a0.y) + w1 * bf_hi(a1.y) + w2 * bf_hi(a2.y);
        v[4] = w0 * bf_lo(a0.z) + w1 * bf_lo(a1.z) + w2 * bf_lo(a2.z); v[5] = w0 * bf_hi(a0.z) + w1 * bf_hi(a1.z) + w2 * bf_hi(a2.z);
        v[6] = w0 * bf_lo(a0.w) + w1 * bf_lo(a1.w) + w2 * bf_lo(a2.w); v[7] = w0 * bf_hi(a0.w) + w1 * bf_hi(a1.w) + w2 * bf_hi(a2.w);
        float ss = 0.f;
#pragma unroll
        for (int j = 0; j < 8; ++j) ss += v[j] * v[j];
        ss = wave_sum(ss);
        float rstd = rsqrtf(ss * (1.0f / AW) + NORM_EPS);
        { const f32x4 g0 = *(const f32x4*)(g_a + 8 * lane), g1 = *(const f32x4*)(g_a + 8 * lane + 4);
          u32x4 w; w.x = pk_bf16(v[0] * rstd * g0[0], v[1] * rstd * g0[1]); w.y = pk_bf16(v[2] * rstd * g0[2], v[3] * rstd * g0[3]); w.z = pk_bf16(v[4] * rstd * g1[0], v[5] * rstd * g1[1]); w.w = pk_bf16(v[6] * rstd * g1[2], v[7] * rstd * g1[3]);
          *(u32x4*)(MIX + (size_t)t * DM + 8 * lane) = w; }
        if (CR == nullptr) continue;
        const u32x4 c0 = *(const u32x4*)(CR + (size_t)t * CW + 8 * lane);
        v[0] = bf_lo(c0.x); v[1] = bf_hi(c0.x); v[2] = bf_lo(c0.y); v[3] = bf_hi(c0.y); v[4] = bf_lo(c0.z); v[5] = bf_hi(c0.z); v[6] = bf_lo(c0.w); v[7] = bf_hi(c0.w);
        ss = 0.f;
#pragma unroll
        for (int j = 0; j < 8; ++j) ss += v[j] * v[j];
        ss = wave_sum(ss);
        rstd = rsqrtf(ss * (1.0f / CW) + NORM_EPS);
        { const f32x4 g0 = *(const f32x4*)(g_c + 8 * lane), g1 = *(const f32x4*)(g_c + 8 * lane + 4);
          u32x4 w; w.x = pk_bf16(v[0] * rstd * g0[0], v[1] * rstd * g0[1]); w.y = pk_bf16(v[2] * rstd * g0[2], v[3] * rstd * g0[3]); w.z = pk_bf16(v[4] * rstd * g1[0], v[5] * rstd * g1[1]); w.w = pk_bf16(v[6] * rstd * g1[2], v[7] * rstd * g1[3]);
          *(u32x4*)(MIX + (size_t)t * DM + AW + 8 * lane) = w; }
    }
}

__device__ __forceinline__ void ins8(float (&tv)[8], int (&ti)[8], float cv, int ci) {
#pragma unroll
    for (int p = 0; p < 8; ++p) { const bool gt = cv > tv[p]; const float ov = tv[p]; const int oi = ti[p]; tv[p] = gt ? cv : ov; ti[p] = gt ? ci : oi; cv = gt ? ov : cv; ci = gt ? oi : ci; }
}
__device__ __forceinline__ void route_phase(const Args& a, LAS unsigned char* lds, int gcnt_off) {
    const int tid = threadIdx.x, lane = tid & 63, j4 = tid & 3;
    unsigned char* ws = a.ws;
    const float* logits = (const float*)(ws + WS_ZB); const float* b_r = a.in[18];
    int* IDX = (int*)(ws + WS_IDX); float* RW = (float*)(ws + WS_RW); int* POS = (int*)(ws + WS_POS);
    unsigned* gcnt = (unsigned*)(ws + WS_CTL) + gcnt_off;
    LAS float* bias = (LAS float*)lds;
    LAS int* hist = (LAS int*)(lds + 1024);
    LAS int* base = (LAS int*)(lds + 2048);
    for (int i = tid; i < NEXP; i += 512) bias[i] = b_r[i];
    for (int blk = blockIdx.x; blk < NT / 128; blk += gridDim.x) {
        for (int i = tid; i < NEXP; i += 512) hist[i] = 0;
        __syncthreads();
        const int t = blk * 128 + (tid >> 2);
        float sb[64];
        { const f32x4* lp = (const f32x4*)(logits + (size_t)t * NEXP + 64 * j4);
#pragma unroll
          for (int c = 0; c < 16; ++c) { const f32x4 x = lp[c];
#pragma unroll
              for (int j = 0; j < 4; ++j) sb[4 * c + j] = 1.0f / (1.0f + expf(-x[j])) + bias[64 * j4 + 4 * c + j]; } }
        float gs2[2];
#pragma unroll
        for (int g = 0; g < 2; ++g) { float m1 = -1e30f, m2 = -1e30f;
#pragma unroll
            for (int i = 0; i < 32; ++i) { const float v = sb[32 * g + i]; const float n1 = fmaxf(m1, v); m2 = fmaxf(m2, fminf(m1, v)); m1 = n1; }
            gs2[g] = m1 + m2; }
        float gs[8];
#pragma unroll
        for (int g = 0; g < 8; ++g) gs[g] = __shfl((g & 1) ? gs2[1] : gs2[0], (lane & ~3) | (g >> 1));
        bool sel[2];
#pragma unroll
        for (int g2 = 0; g2 < 2; ++g2) { const int g = 2 * j4 + g2; const float me = (g2 == 0) ? gs2[0] : gs2[1]; int rank = 0;
#pragma unroll
            for (int o = 0; o < 8; ++o) rank += (gs[o] > me || (gs[o] == me && o < g)) ? 1 : 0;
            sel[g2] = rank < 4; }
        float tv[8]; int ti[8];
#pragma unroll
        for (int p = 0; p < 8; ++p) { tv[p] = -3e38f; ti[p] = 0; }
#pragma unroll
        for (int i = 0; i < 64; ++i) { const float v = sel[i >> 5] ? sb[i] : -1e30f; ins8(tv, ti, v, 64 * j4 + i); }
        float mv[8]; int mi[8];
#pragma unroll
        for (int p = 0; p < 8; ++p) { mv[p] = -3e38f; mi[p] = 0; }
#pragma unroll
        for (int src = 0; src < 4; ++src)
#pragma unroll
            for (int p = 0; p < 8; ++p) { const float v = __shfl(tv[p], (lane & ~3) | src); const int ix = __shfl(ti[p], (lane & ~3) | src); ins8(mv, mi, v, ix); }
        float wsum = 0.f; float wv[8];
#pragma unroll
        for (int p = 0; p < 8; ++p) { wv[p] = mv[p] - bias[mi[p]]; wsum += wv[p]; }
        const float wscale = 2.5f / wsum;
        int myk[2], mye[2], myr[2]; float myw[2];
#pragma unroll
        for (int p = 0; p < 8; ++p) { if ((p >> 1) == j4) { myk[p & 1] = p; mye[p & 1] = mi[p]; myw[p & 1] = wv[p] * wscale; } }
#pragma unroll
        for (int q = 0; q < 2; ++q) myr[q] = atomicAdd((int*)&hist[mye[q]], 1);
        __syncthreads();
        if (tid < NEXP) { const int h = hist[tid]; base[tid] = h ? (int)atomicAdd(&gcnt[tid * 32], (unsigned)h) : 0; }
        __syncthreads();
#pragma unroll
        for (int q = 0; q < 2; ++q) { const size_t o = (size_t)t * 8 + myk[q]; IDX[o] = mye[q]; RW[o] = myw[q]; POS[o] = base[mye[q]] + myr[q]; }
        __syncthreads();
    }
}

__device__ __forceinline__ void dispatch_phase(const Args& a, LAS unsigned char* lds) {
    const int tid = threadIdx.x;
    unsigned char* ws = a.ws;
    unsigned* ctl = (unsigned*)(ws + WS_CTL);
    const int* IDX = (const int*)(ws + WS_IDX); int* POS = (int*)(ws + WS_POS);
    int* AIDS = (int*)(ws + WS_AIDS); int* TEXP = (int*)(ws + WS_TEXP);
    LAS int* cnt = (LAS int*)lds; LAS int* pst = (LAS int*)(lds + 1024);
    for (int i = tid; i < NEXP; i += 512) cnt[i] = (int)ctl[CW_GCNT + i * 32];
    __syncthreads();
    if (tid == 0) { int s = 0; for (int e = 0; e < NEXP; ++e) { pst[e] = s; s += (cnt[e] + 255) & ~255; } pst[NEXP] = s; }
    __syncthreads();
    for (int id = blockIdx.x * 512 + tid; id < NT * 8; id += gridDim.x * 512) { const int e = IDX[id]; const int slot = pst[e] + POS[id]; AIDS[slot] = id; POS[id] = slot; }
    for (int e = blockIdx.x; e < NEXP; e += gridDim.x) {
        const int c = cnt[e], pc = (c + 255) & ~255, s0 = pst[e];
        for (int i = c + tid; i < pc; i += 512) AIDS[s0 + i] = -1;
        for (int i = tid; i < pc / 256; i += 512) TEXP[s0 / 256 + i] = e;
    }
    if (blockIdx.x == 0 && tid == 0) ctl[CW_NTILES] = (unsigned)(pst[NEXP] / 256);
}

__device__ __forceinline__ void final_phase(const Args& a, float* dst) {
    const int lane = threadIdx.x & 63, wave = __builtin_amdgcn_readfirstlane(threadIdx.x >> 6);
    const unsigned char* Y = a.ws + WS_YBUF; const bf16_t* X1 = (const bf16_t*)(a.ws + WS_X1B);
    const float* RW = (const float*)(a.ws + WS_RW);
    const float* gate = (const float*)(a.ws + WS_ADA) + 5120; const float* gf = a.in[25];
    for (int t = blockIdx.x * 8 + wave; t < NT; t += gridDim.x * 8) {
        const int b = t >> 13;
        float rw[9];
#pragma unroll
        for (int k = 0; k < 8; ++k) rw[k] = RW[(size_t)t * 8 + k] * 0.0625f;
        rw[8] = 0.0625f;
        u32x4 yw[9];
#pragma unroll
        for (int k = 0; k < 9; ++k) yw[k] = *(const u32x4*)(Y + ((size_t)t * 9 + k) * DM + 16 * lane);
        const u32x4 xw0 = *(const u32x4*)(X1 + (size_t)t * DM + 16 * lane), xw1 = *(const u32x4*)(X1 + (size_t)t * DM + 16 * lane + 8);
        float acc[16];
#pragma unroll
        for (int i = 0; i < 16; ++i) acc[i] = 0.f;
#pragma unroll
        for (int k = 0; k < 9; ++k)
#pragma unroll
            for (int q = 0; q < 4; ++q) { const int w = (int)yw[k][q];
                const f32x2 lo = __builtin_amdgcn_cvt_pk_f32_fp8(w, false), hi = __builtin_amdgcn_cvt_pk_f32_fp8(w, true);
                acc[4 * q + 0] += rw[k] * lo[0]; acc[4 * q + 1] += rw[k] * lo[1]; acc[4 * q + 2] += rw[k] * hi[0]; acc[4 * q + 3] += rw[k] * hi[1]; }
        float xv[16];
        xv[0] = bf_lo(xw0.x); xv[1] = bf_hi(xw0.x); xv[2] = bf_lo(xw0.y); xv[3] = bf_hi(xw0.y); xv[4] = bf_lo(xw0.z); xv[5] = bf_hi(xw0.z); xv[6] = bf_lo(xw0.w); xv[7] = bf_hi(xw0.w);
        xv[8] = bf_lo(xw1.x); xv[9] = bf_hi(xw1.x); xv[10] = bf_lo(xw1.y); xv[11] = bf_hi(xw1.y); xv[12] = bf_lo(xw1.z); xv[13] = bf_hi(xw1.z); xv[14] = bf_lo(xw1.w); xv[15] = bf_hi(xw1.w);
        float v[16]; float ss = 0.f;
#pragma unroll
        for (int q = 0; q < 4; ++q) { const f32x4 gv = *(const f32x4*)(gate + (size_t)b * 6144 + 16 * lane + 4 * q);
#pragma unroll
            for (int j = 0; j < 4; ++j) { const float y = xv[4 * q + j] + gv[j] * acc[4 * q + j]; v[4 * q + j] = y; ss += y * y; } }
        ss = wave_sum(ss);
        const float rstd = rsqrtf(ss * (1.0f / DM) + NORM_EPS);
#pragma unroll
        for (int q = 0; q < 4; ++q) { const f32x4 gv = *(const f32x4*)(gf + 16 * lane + 4 * q);
            f32x4 o; o[0] = v[4 * q + 0] * rstd * gv[0]; o[1] = v[4 * q + 1] * rstd * gv[1]; o[2] = v[4 * q + 2] * rstd * gv[2]; o[3] = v[4 * q + 3] * rstd * gv[3];
            *(f32x4*)(dst + (size_t)t * DM + 16 * lane + 4 * q) = o; }
    }
}

extern __shared__ __attribute__((aligned(16))) unsigned char dyn_lds[];

__global__ void __launch_bounds__(512, 2) __attribute__((amdgpu_waves_per_eu(2, 2))) hymba_fwd(Args a) {
    LAS unsigned char* lds = (LAS unsigned char*)dyn_lds;
    const int tid = threadIdx.x, G = gridDim.x, bx = blockIdx.x;
    unsigned char* ws = a.ws;
    unsigned* ctl = (unsigned*)(ws + WS_CTL);
    if (tid < 4) ((LAS unsigned*)(lds + LDS_BAR_OFF))[tid] = 0u;
    __syncthreads();
    XcdBarrier bar; bar.bar = ctl + CW_BAR; bar.x = 0; bar.st = (volatile LAS unsigned*)(lds + LDS_BAR_OFF);
    const bool one_launch = (a.ph_hi - a.ph_lo) > 1;
    if (one_launch) bar = xcd_barrier_post(ctl + CW_BAR, (volatile LAS unsigned*)(lds + LDS_BAR_OFF));
#define IN(k) (a.ph_lo <= (k) && (k) < a.ph_hi)
#define SEAM(k) do { if (IN(k) && IN((k) + 1)) xcd_barrier(bar); } while (0)
    const float* ada = (const float*)(ws + WS_ADA);
    const bool has_conv = (G == 256);
    const int Gc = has_conv ? 183 : G, cx = bx, nconv = G - Gc, kconv = bx - Gc; const bool is_conv = has_conv && bx >= Gc;
    constexpr int J8 = JOBS_F8 - 1024;
    constexpr int JSPLIT = 3900;
    const bool has_conv3 = has_conv;
    const int G3 = has_conv3 ? 171 : G, c3 = bx, nconv3 = G - G3, kconv3 = bx - G3; const bool is_conv3 = has_conv3 && bx >= G3;

#define RUN(k, ...) do { if (IN((k) % 100)) { __VA_ARGS__ } if (PROBE_PH == (k)) { if (IN((k) % 100)) { __VA_ARGS__ } if (IN((k) % 100)) { __VA_ARGS__ } } } while (0)
    RUN(0, p0_prologue(a, lds); );
    SEAM(0);
    RUN(1, normmod_phase(a.in[0], a.in[3], ada + 0, ada + 1024, (bf16_t*)(ws + WS_HB)); );
    SEAM(1);
    RUN(2,
        if (is_conv) convert_f8_jobs(a, lds, 0, JSPLIT, kconv, nconv);
        else {
        GemmDense g{(const char*)(ws + WS_HB), (const char*)(ws + WS_WIN), NT, NPROJ, DM * 2, DM * 2, Gc, cx};
        EpiInProj E{(bf16_t*)(ws + WS_QKV), (bf16_t*)(ws + WS_AB), (const float*)(ws + WS_ROPE)};
        gemm_phase(lds, g, E);
        }
    );
    SEAM(2);
#define P3X(AM_) do { if (IN(3) && !is_conv3) { const bf16_t* Q = (const bf16_t*)(ws + WS_QKV); const bf16_t* Kb = Q + (size_t)NT * AW; const bf16_t* Vb = Kb + (size_t)NT * AW; \
        for (int rep_ = 0; rep_ < 2; ++rep_) for (int u = c3; u < NB * NHEAD * 3 * 32; u += G3) attn_unit<AM_>(u, lds, Q, Kb, Vb, (bf16_t*)(ws + WS_OB), (float*)(ws + WS_LSE)); } } while (0)
    if (PROBE_PH == 1003) P3X(1);
    if (PROBE_PH == 2003) P3X(2);
    if (PROBE_PH == 3003) P3X(3);
    if (PROBE_PH == 4003) P3X(0);
    RUN(3,
        const bf16_t* Q = (const bf16_t*)(ws + WS_QKV); const bf16_t* Kb = Q + (size_t)NT * AW; const bf16_t* Vb = Kb + (size_t)NT * AW;
        if (!has_conv3 && has_conv) { if (is_conv) convert_f8_jobs(a, lds, JSPLIT, JOBS_F8, kconv, nconv); else for (int u = cx; u < NB * NHEAD * 3 * 32; u += Gc) attn_unit(u, lds, Q, Kb, Vb, (bf16_t*)(ws + WS_OB), (float*)(ws + WS_LSE)); }
        else if (is_conv3) convert_f8_jobs(a, lds, JSPLIT, has_conv ? J8 : JOBS_F8, kconv3, nconv3);
        else for (int u = c3; u < NB * NHEAD * 3 * 32; u += G3) attn_unit(u, lds, Q, Kb, Vb, (bf16_t*)(ws + WS_OB), (float*)(ws + WS_LSE));
    );
    RUN(103,
        for (int u = bx; u < NT / 32; u += G) conv_unit(u, lds, (const bf16_t*)(ws + WS_AB), a.in[7], a.in[8], a.in[9], a.in[10], (bf16_t*)(ws + WS_ZB));
    );
    SEAM(3);
    RUN(4,
        GemmDense g{(const char*)(ws + WS_ZB), (const char*)(ws + WS_WPW2), NT, CW, CW * 2, CW * 2, G, bx};
        EpiPw2Norm E{a.in[12], a.in[14], (bf16_t*)(ws + WS_QKV), (float*)(ws + WS_RWS) + 262144, ctl + CW_PANEL2, lds + LDS_XCH_OFF};
        gemm_phase(lds, g, E);
        mix_phase((const bf16_t*)(ws + WS_OB), (const float*)(ws + WS_LSE), nullptr, a.in[13], a.in[14], (bf16_t*)(ws + WS_QKV));
    );
    SEAM(5);
    RUN(6,
        GemmDense g{(const char*)(ws + WS_QKV), (const char*)(ws + WS_WOUT), NT, DM, DM * 2, DM * 2, G, bx};
        EpiOutNorm E{a.in[0], (bf16_t*)(ws + WS_X1B), ada, a.in[16], (bf16_t*)(ws + WS_HB), (unsigned char*)(ws + WS_H2F8), (float*)(ws + WS_RWS), ctl + CW_PANEL, lds + LDS_XCH_OFF};
        gemm_phase(lds, g, E);
    );
    SEAM(6);
    RUN(8,
        if (has_conv && bx >= 128) convert_f8_jobs(a, lds, J8, JOBS_F8, bx - 128, 128);
        else {
        GemmDense g{(const char*)(ws + WS_HB), (const char*)(ws + WS_WR), NT, NEXP, DM * 2, DM * 2, G, bx};
        EpiF32 E{(float*)(ws + WS_ZB), NEXP};
        gemm_phase(lds, g, E); }
    );
    SEAM(8);
    if (PROBE_PH == 9) { route_phase(a, lds, CW_GCNT + 8); route_phase(a, lds, CW_GCNT + 16); }
    RUN(109, route_phase(a, lds, CW_GCNT); );
    SEAM(9);
    RUN(10, dispatch_phase(a, lds); );
    SEAM(10);
#define P11X(MODE_) do { if (IN(11)) { const int ntiles = (int)__hip_atomic_load(ctl + CW_NTILES, __ATOMIC_RELAXED, __HIP_MEMORY_SCOPE_AGENT); \
        GemmGU g{(const char*)(ws + WS_H2F8), (const char*)(ws + WS_WGU), (const int*)(ws + WS_AIDS), (const int*)(ws + WS_TEXP), ntiles, DM, G, bx, lds + LDS_XCH_OFF + 20480}; EpiGU E{(unsigned char*)(ws + WS_HBUF)}; \
        gemm_phase<MODE_>(lds, g, E); gemm_phase<MODE_>(lds, g, E); } } while (0)
    if (PROBE_PH == 1011) P11X(1);
    if (PROBE_PH == 2011) P11X(2);
    if (PROBE_PH == 3011) P11X(3);
#define P12X(MODE_) do { if (IN(12)) { const int ntiles = (int)__hip_atomic_load(ctl + CW_NTILES, __ATOMIC_RELAXED, __HIP_MEMORY_SCOPE_AGENT); \
        GemmDown g{(const char*)(ws + WS_HBUF), (const char*)(ws + WS_WDT), (const int*)(ws + WS_TEXP), ntiles, FE, G, bx}; EpiDown E{(unsigned char*)(ws + WS_YBUF), lds + LDS_XCH_OFF, (const int*)(ws + WS_AIDS)}; \
        gemm_phase<MODE_>(lds, g, E); gemm_phase<MODE_>(lds, g, E); } } while (0)
    RUN(11,
        const int ntiles = (int)__hip_atomic_load(ctl + CW_NTILES, __ATOMIC_RELAXED, __HIP_MEMORY_SCOPE_AGENT);
        GemmGU g{(const char*)(ws + WS_H2F8), (const char*)(ws + WS_WGU), (const int*)(ws + WS_AIDS), (const int*)(ws + WS_TEXP), ntiles, DM, G, bx, lds + LDS_XCH_OFF + 20480};
        EpiGU E{(unsigned char*)(ws + WS_HBUF)};
        gemm_phase(lds, g, E);
    );
    SEAM(11);
    if (PROBE_PH == 1012) P12X(1);
    if (PROBE_PH == 2012) P12X(2);
    if (PROBE_PH == 3012) P12X(3);
    RUN(12,
        const int ntiles = (int)__hip_atomic_load(ctl + CW_NTILES, __ATOMIC_RELAXED, __HIP_MEMORY_SCOPE_AGENT);
        GemmDown g{(const char*)(ws + WS_HBUF), (const char*)(ws + WS_WDT), (const int*)(ws + WS_TEXP), ntiles, FE, G, bx};
        EpiDown E{(unsigned char*)(ws + WS_YBUF), lds + LDS_XCH_OFF, (const int*)(ws + WS_AIDS)};
        gemm_phase(lds, g, E);
    );
    SEAM(12);
    RUN(13, final_phase(a, a.out); );
#undef RUN
#undef IN
#undef SEAM
}

extern "C" void kernel_launch(void* const* d_in, const int* in_sizes, int n_in, void* d_out, int out_size, void* d_ws, size_t ws_size, hipStream_t stream) {
    static int grid = 0;
    if (grid == 0) {
        if (n_in != 26 || out_size != NT * DM || ws_size < WS_END) { fprintf(stderr, "kernel_launch: unexpected problem (n_in %d out %d ws %zu need %zu)\n", n_in, out_size, ws_size, (size_t)WS_END); grid = -1; return; }
        int dev = 0, cus = 0, per_cu = 0;
        if (hipGetDevice(&dev) != hipSuccess || hipDeviceGetAttribute(&cus, hipDeviceAttributeMultiprocessorCount, dev) != hipSuccess) { grid = -1; return; }
        if (hipFuncSetAttribute((const void*)hymba_fwd, hipFuncAttributeMaxDynamicSharedMemorySize, LDS_BYTES) != hipSuccess) { fprintf(stderr, "kernel_launch: hipFuncSetAttribute failed\n"); grid = -1; return; }
        if (hipOccupancyMaxActiveBlocksPerMultiprocessor(&per_cu, (const void*)hymba_fwd, 512, LDS_BYTES) != hipSuccess || per_cu < 1) fprintf(stderr, "kernel_launch: occupancy query says %d\n", per_cu);
        (void)hipGetLastError();
        grid = cus;
    }
    if (grid < 0) return;
    (void)hipMemsetAsync((char*)d_ws + WS_CTL, 0, CTL_BYTES, stream);
    Args a{};
    for (int i = 0; i < 26; ++i) a.in[i] = (const float*)d_in[i];
    a.out = (float*)d_out; a.ws = (unsigned char*)d_ws;
#if MK_N_LAUNCHES == 1
    a.ph_lo = 0; a.ph_hi = NPHASE;
    hipLaunchKernelGGL(hymba_fwd, dim3(grid), dim3(512), LDS_BYTES, stream, a);
#else
    for (int p = 0; p < NPHASE; ++p) { a.ph_lo = p; a.ph_hi = p + 1; hipLaunchKernelGGL(hymba_fwd, dim3(grid), dim3(512), LDS_BYTES, stream, a); }
#endif
}
```

```cpp
#include <hip/hip_runtime.h>
#include <stdint.h>
#include <stdio.h>

#ifndef MK_N_LAUNCHES
#define MK_N_LAUNCHES 1
#endif

#ifndef PROBE_PH
#define PROBE_PH (-1)
#endif

#define LAS __attribute__((address_space(3)))
typedef unsigned short bf16_t;
typedef short bf16x8 __attribute__((ext_vector_type(8)));
typedef float f32x4 __attribute__((ext_vector_type(4)));
typedef float f32x2 __attribute__((ext_vector_type(2)));
typedef unsigned u32x4 __attribute__((ext_vector_type(4)));
typedef unsigned u32x2 __attribute__((ext_vector_type(2)));

constexpr int NB = 4, SEQ = 8192, DM = 1024, NT = NB * SEQ;
constexpr int AW = 512, CW = 512, NHEAD = 8, HD = 64, NPROJ = 2560;
constexpr int NEXP = 256, TOPK = 8, FE = 256, CONVK = 31;
constexpr int NSLOT_MAX = NT * TOPK + NEXP * 256;
constexpr float NORM_EPS = 1e-6f;

constexpr size_t al256(size_t x) { return (x + 255) & ~(size_t)255; }
constexpr size_t WS_CTL   = 0;
constexpr size_t CTL_BYTES = 196608;
constexpr size_t WS_ADA   = WS_CTL + CTL_BYTES;
constexpr size_t WS_ROPE  = WS_ADA + al256((size_t)NB * 6144 * 4);
constexpr size_t WS_IDX   = WS_ROPE + (size_t)NT * 16 * 4;
constexpr size_t WS_RW    = WS_IDX + (size_t)NT * 8 * 4;
constexpr size_t WS_POS   = WS_RW + (size_t)NT * 8 * 4;
constexpr size_t WS_AIDS  = WS_POS + (size_t)NT * 8 * 4;
constexpr size_t WS_RWS   = WS_AIDS + (size_t)NSLOT_MAX * 4;
constexpr size_t WS_TEXP  = WS_RWS + (size_t)NSLOT_MAX * 4;
constexpr size_t WS_WDT   = WS_TEXP + 8192;
constexpr size_t WS_HBUF  = WS_WDT + (size_t)257 * 1024 * 256;
constexpr size_t WS_X1B   = WS_HBUF + (size_t)(NSLOT_MAX + NT) * 256;
constexpr size_t WS_OV    = WS_X1B + (size_t)NT * 1024 * 2;
constexpr size_t WS_WGU   = WS_OV;
constexpr size_t WS_WIN   = WS_WGU + (size_t)257 * 512 * 1024;
constexpr size_t WS_WOUT  = WS_WIN + (size_t)2560 * 1024 * 2;
constexpr size_t WS_WPW2  = WS_WOUT + (size_t)1024 * 1024 * 2;
constexpr size_t WS_WR    = WS_WPW2 + (size_t)512 * 512 * 2;
constexpr size_t WS_HB    = WS_WR + (size_t)256 * 1024 * 2;
constexpr size_t WS_QKV   = WS_HB + (size_t)NT * 1024 * 2;
constexpr size_t WS_AB    = WS_QKV + (size_t)3 * NT * 512 * 2;
constexpr size_t WS_OB    = WS_AB + (size_t)NT * 512 * 2;
constexpr size_t WS_LSE   = WS_OB + (size_t)3 * NT * 512 * 2;
constexpr size_t WS_ZB    = WS_LSE + (size_t)3 * NT * 8 * 4;
constexpr size_t WS_H2F8  = WS_ZB + (size_t)NT * 512 * 2;
constexpr size_t WS_OVEND = WS_H2F8 + (size_t)NT * 1024;
constexpr size_t WS_YBUF  = WS_OV;
constexpr size_t WS_YEND  = WS_YBUF + (size_t)NT * 9 * 1024;
constexpr size_t WS_END   = WS_OVEND > WS_YEND ? WS_OVEND : WS_YEND;
static_assert(WS_END <= (size_t)1 << 30, "workspace plan must fit 1 GiB");

constexpr int CW_BAR = 0;
constexpr int CW_GCNT = 8192;
constexpr int CW_NTILES = 4096 + 256;
constexpr int CW_PANEL2 = 32768;
constexpr int CW_PANEL = 16384;

constexpr int LDS_STAGE = 131072;
constexpr int LDS_BAR_OFF = LDS_STAGE;
constexpr int LDS_XCH_OFF = LDS_STAGE + 64;
constexpr int LDS_BYTES = 155648;

__device__ __forceinline__ unsigned pk_bf16(float lo, float hi) { unsigned r; asm volatile("v_cvt_pk_bf16_f32 %0, %1, %2" : "=v"(r) : "v"(lo), "v"(hi)); return r; }
__device__ __forceinline__ unsigned pk4_fp8(float a, float b, float c, float d) { int w = __builtin_amdgcn_cvt_pk_fp8_f32(a, b, 0, false); w = __builtin_amdgcn_cvt_pk_fp8_f32(c, d, w, true); return (unsigned)w; }
__device__ __forceinline__ float bf_lo(unsigned w) { return __uint_as_float(w << 16); }
__device__ __forceinline__ float bf_hi(unsigned w) { return __uint_as_float(w & 0xffff0000u); }
__device__ __forceinline__ float sigmoid_fast(float x) { return __builtin_amdgcn_rcpf(1.0f + __expf(-x)); }
__device__ __forceinline__ float silu_fast(float x) { return x * __builtin_amdgcn_rcpf(1.0f + __expf(-x)); }
__device__ __forceinline__ float wave_sum(float v) {
#pragma unroll
    for (int o = 32; o > 0; o >>= 1) v += __shfl_xor(v, o);
    return v;
}

#define XB_TMO      128
#define XB_XCNT(j)  (256  + 64 * (j))
#define XB_XSUB(j)  (1280 + 64 * (j))
#define XB_XGEN(j)  (2304 + 64 * (j))
#define XB_TOP      3328
#define XB_TOPGEN   3392
#define XCD_BAR_WORDS 3456
#define XB_SPIN_CAP (1u << 18)

__device__ __forceinline__ unsigned xb_ld(unsigned* p)              { return __hip_atomic_load(p, __ATOMIC_RELAXED, __HIP_MEMORY_SCOPE_AGENT); }
__device__ __forceinline__ unsigned xb_add(unsigned* p, unsigned v) { return __hip_atomic_fetch_add(p, v, __ATOMIC_RELAXED, __HIP_MEMORY_SCOPE_AGENT); }
__device__ __forceinline__ unsigned xb_xcc_id() { return (unsigned)__builtin_amdgcn_s_getreg((3 << 11) | 20) & 0xFu; }
#define XB_SPIN(cond, bar) do { unsigned _sp = 0; while (cond) { __builtin_amdgcn_s_sleep(1); \
    if ((++_sp & 255u) == 0u) { if (xb_ld(&(bar)[XB_TMO])) break; if (_sp > XB_SPIN_CAP) { atomicAdd(&(bar)[XB_TMO], 1u); break; } } } } while (0)

struct XcdBarrier { unsigned* bar; unsigned x; volatile LAS unsigned* st; };

__device__ __forceinline__ XcdBarrier xcd_barrier_post(unsigned* bar, volatile LAS unsigned* st) {
    XcdBarrier b; b.bar = bar; b.x = xb_xcc_id(); b.st = st;
    if (threadIdx.x == 0) (void)xb_add(&bar[XB_XCNT(b.x)], 1u);
    return b;
}
__device__ __forceinline__ void xcd_barrier_complete(unsigned* bar, unsigned x, unsigned& nloc, unsigned& nx) {
    const unsigned G = gridDim.x * gridDim.y * gridDim.z;
    unsigned sum, cnt, mine, sp = 0u;
    for (;;) {
        sum = 0u; cnt = 0u; mine = 0u;
#pragma unroll
        for (unsigned j = 0; j < 16; ++j) { const unsigned c = xb_ld(&bar[XB_XCNT(j)]); sum += c; cnt += (c > 0u) ? 1u : 0u; mine = (j == x) ? c : mine; }
        if (sum == G) break;
        __builtin_amdgcn_s_sleep(1);
        if ((++sp & 255u) == 0u) { if (xb_ld(&bar[XB_TMO])) break; if (sp > XB_SPIN_CAP) { atomicAdd(&bar[XB_TMO], 1u); break; } }
    }
    nloc = mine > 0u ? mine : 1u; nx = cnt > 0u ? cnt : 1u;
}
__device__ __forceinline__ void xcd_barrier(const XcdBarrier& b) {
    asm volatile("s_waitcnt vmcnt(0)" ::: "memory");
    __syncthreads();
    if (threadIdx.x == 0) {
        unsigned* bar = b.bar;
        __builtin_amdgcn_s_waitcnt(0);
        unsigned nloc = b.st[0], nx = b.st[1];
        if (nloc == 0u) { xcd_barrier_complete(bar, b.x, nloc, nx); b.st[0] = nloc; b.st[1] = nx; }
        const unsigned old = xb_add(&bar[XB_XSUB(b.x)], 1u);
        const unsigned gen = old / nloc;
        if (old + 1u == (gen + 1u) * nloc) {
            __builtin_amdgcn_fence(__ATOMIC_RELEASE, "agent");
            asm volatile("s_waitcnt vmcnt(0)" ::: "memory");
            const unsigned og = xb_add(&bar[XB_TOP], 1u);
            const unsigned tg = og / nx;
            if (og + 1u == (tg + 1u) * nx) xb_add(&bar[XB_TOPGEN], 1u);
            else XB_SPIN(xb_ld(&bar[XB_TOPGEN]) == tg, bar);
            __builtin_amdgcn_fence(__ATOMIC_ACQUIRE, "agent");
            xb_add(&bar[XB_XGEN(b.x)], 1u);
            asm volatile("s_waitcnt vmcnt(0)" ::: "memory");
        } else {
            XB_SPIN(xb_ld(&bar[XB_XGEN(b.x)]) == gen, bar);
            __builtin_amdgcn_fence(__ATOMIC_ACQUIRE, "agent");
            asm volatile("s_waitcnt vmcnt(0)" ::: "memory");
        }
    }
    __syncthreads();
}

constexpr int BM = 256, BK = 64, HALF = 128, HTB = HALF * BK * 2, NXCD = 8, WGM = 8;

__host__ __device__ __forceinline__ int lds_byte(int r, int c) { const int st = (r >> 4) * 2 + (c >> 5), rr = r & 15, cc = c & 31, ob = rr * 64 + cc * 2; return st * 1024 + (ob ^ (((ob >> 9) & 1) << 5)); }
__host__ __device__ __forceinline__ void stage_rc(int b, int& R, int& C) { const int st = b / 1024, sb = b % 1024, swz = sb ^ (((sb >> 9) & 1) << 5); R = (st >> 1) * 16 + swz / 64; C = (st & 1) * 32 + (swz % 64) / 2; }
__host__ __device__ __forceinline__ int perm32(int rho) { const int n = rho >> 4, i = rho & 15; return 8 * (i >> 2) + 4 * n + (i & 3); }

__host__ __device__ __forceinline__ int g8(int r16) { const int h = r16 >> 1; return (h < 2) ? h : (h < 6 ? h + 2 : h - 4); }
struct Unit { int pm, pn, e, kind; };

struct GemmDense {
    static constexpr bool F8 = false, GATHER = false;
    const char* A; const char* Bt; int M, N, KB, ldaB; int G, c;
    __device__ __forceinline__ bool next(int i, Unit& u) const {
        const int nM = M / BM, nN = N / BM, nwg = nM * nN;
        const long L = (long)i * G + c; if (L >= nwg) return false;
        int wgid = (int)L; { const int q = nwg / NXCD, r = nwg % NXCD, xcd = wgid % NXCD, off = wgid / NXCD; wgid = (xcd < r ? xcd * (q + 1) : r * (q + 1) + (xcd - r) * q) + off; }
        const int nig = WGM * nN, gid = wgid / nig, fm = gid * WGM, gsz = (nM - fm) < WGM ? (nM - fm) : WGM;
        u.pm = fm + ((wgid % nig) % gsz); u.pn = (wgid % nig) / gsz; u.e = i; u.kind = 0; return true;
    }
    __device__ __forceinline__ const char* a_base() const { return A; }
    __device__ __forceinline__ void a_off(const Unit& u, unsigned (&off)[2][2]) const {
        int tz = threadIdx.x; asm volatile("" : "+v"(tz));
#pragma unroll
        for (int i = 0; i < 2; ++i) { int R, C; stage_rc(tz * 16 + i * 8192, R, C);
#pragma unroll
            for (int h = 0; h < 2; ++h) off[h][i] = (unsigned)((size_t)(u.pm * BM + h * HALF + R) * ldaB + C * 2); }
    }
    __device__ __forceinline__ const char* b_ptr(const Unit& u) const { return Bt + (size_t)u.pn * BM * KB; }
    __device__ __forceinline__ const char* a_unit(const Unit& u) const { return A + (size_t)u.pm * BM * ldaB; }
    __device__ __forceinline__ int a_row_bytes() const { return ldaB; }
};

__device__ __forceinline__ int sload_i32(const int* p) { int v; asm volatile("s_load_dword %0, %1, 0x0\n\ts_waitcnt lgkmcnt(0)" : "=s"(v) : "s"(p) : "memory"); return v; }
struct GemmGU {
    static constexpr bool F8 = true, GATHER = true;
    const char* A; const char* W; const int* aids; const int* texp; int ntiles; int KB; int G, c; LAS unsigned char* idx;
    __device__ __forceinline__ bool next(int i, Unit& u) const {
        const int L = i * G + (((G & 7) == 0) ? (c & 7) * (G >> 3) + (c >> 3) : c); if (L >= (ntiles + NT / BM) * 2) return false;
        const int tile = L >> 1; u.pn = L & 1;
        if (tile < ntiles) { u.e = sload_i32(texp + tile); u.pm = tile * BM; u.kind = 0; } else { u.e = NEXP; u.pm = NSLOT_MAX + (tile - ntiles) * BM; u.kind = 1; }
        return true;
    }
    __device__ __forceinline__ const char* a_base() const { return A; }
    __device__ __forceinline__ void idx_issue(int upm, int ukind, int par, int wid) const {
        int tz = threadIdx.x; asm volatile("" : "+v"(tz)); const int lane = tz & 63;
        const int row = upm + (wid & 3) * 64 + lane;
        __builtin_amdgcn_global_load_lds((const unsigned*)(aids + (ukind == 0 ? row : lane)), (LAS unsigned*)(idx + par * 1024 + (wid & 3) * 256), 4, 0, 0);
    }
    __device__ __forceinline__ void a_off(const Unit& u, int par, unsigned (&off)[2][2]) const {
        int tz = threadIdx.x; asm volatile("" : "+v"(tz));
        const LAS int* ix = (const LAS int*)(idx + par * 1024);
        const bool sh = u.kind != 0;
#pragma unroll
        for (int i = 0; i < 2; ++i) { const int R = (tz >> 3) + 64 * i, C = 8 * ((tz & 7) ^ g8(R & 15));
#pragma unroll
            for (int h = 0; h < 2; ++h) { const int a = ix[h * HALF + R]; const int tok = sh ? u.pm + h * HALF + R - NSLOT_MAX : ((a < 0 ? 0 : a) >> 3);
                off[h][i] = (unsigned)((size_t)tok * DM + C * 2); } }
    }
    __device__ __forceinline__ const char* b_ptr(const Unit& u) const { return W + (size_t)(u.e * 2 + u.pn) * BM * DM; }
    __device__ __forceinline__ const char* a_unit(const Unit&) const { return A; }
    __device__ __forceinline__ int a_row_bytes() const { return DM; }
};
struct GemmDown {
    static constexpr bool F8 = true, GATHER = false;
    const char* A; const char* W; const int* texp; int ntiles; int KB; int G, c;
    __device__ __forceinline__ bool next(int i, Unit& u) const {
        const int L = i * G + (((G & 7) == 0) ? (c & 7) * (G >> 3) + (c >> 3) : c); if (L >= (ntiles + NT / BM) * 4) return false;
        const int tile = L >> 2; u.pn = L & 3;
        if (tile < ntiles) { u.e = sload_i32(texp + tile); u.pm = tile * BM; u.kind = 0; } else { u.e = NEXP; u.pm = NSLOT_MAX + (tile - ntiles) * BM; u.kind = 1; }
        return true;
    }
    __device__ __forceinline__ const char* a_base() const { return A; }
    __device__ __forceinline__ void a_off(const Unit& u, unsigned (&off)[2][2]) const {
        int tz = threadIdx.x; asm volatile("" : "+v"(tz));
#pragma unroll
        for (int i = 0; i < 2; ++i) { int R, C; stage_rc(tz * 16 + i * 8192, R, C);
#pragma unroll
            for (int h = 0; h < 2; ++h) off[h][i] = (unsigned)((size_t)(u.pm + h * HALF + R) * FE + C * 2); }
    }
    __device__ __forceinline__ const char* b_ptr(const Unit& u) const { return W + ((size_t)u.e * DM + (size_t)u.pn * BM) * FE; }
    __device__ __forceinline__ const char* a_unit(const Unit& u) const { return A + (size_t)u.pm * FE; }
    __device__ __forceinline__ int a_row_bytes() const { return FE; }
};

typedef int v8i_t __attribute__((ext_vector_type(8)));
template <bool F8> struct FragA { u32x4 v[4][2]; };
template <> struct FragA<true> { v8i_t v[4]; };
template <bool F8> struct FragB { u32x4 v[2][2]; };
template <> struct FragB<true> { v8i_t v[2]; };
constexpr float F8_WSCALE = 64.0f, F8_WINV = 1.0f / 64.0f;
template <class E, class = void> struct HasPf { static constexpr bool v = false; };
template <class E> struct HasPf<E, decltype((void)E::PF)> { static constexpr bool v = true; };
template <int MODE = 0, class P, class Epi>
__device__ __forceinline__ void gemm_phase(LAS unsigned char* lds, const P& p, const Epi& E) {
    const int tid = threadIdx.x, wid = __builtin_amdgcn_readfirstlane(tid >> 6), lane = tid & 63, wr = wid >> 2, wc = wid & 3, fr = lane & 15, fq = lane >> 4;
    constexpr bool DS = HasPf<Epi>::v && MODE == 0;
    const int KB = p.KB, nt = KB / 128;
    unsigned voffB;
    { int R, C; if constexpr (P::F8) { R = tid >> 3; C = 8 * ((tid & 7) ^ g8(R & 15)); } else stage_rc(tid * 16, R, C);
      const int Rb = Epi::PERM ? ((R & ~31) + perm32(R & 31)) : R; voffB = (unsigned)(Rb * KB + C * 2); }
    const size_t p1B = (size_t)64 * KB;
    const size_t kstep = 128;
    const size_t hstep = (size_t)HALF * KB;
    const unsigned ldsw = (unsigned)wid * 1024u;
    const int foff8 = fr * 128 + 16 * ((2 * fq) ^ g8(fr));
    const int aoff = P::F8 ? wr * 8192 + foff8 : lds_byte(wr * 64 + fr, fq * 8), boff = P::F8 ? wc * 4096 + foff8 : lds_byte(wc * 32 + fr, fq * 8);
    const int aoff2 = aoff ^ 16, boff2 = boff ^ 16;
#define G_SA(b, h) (((b) * 2 + (h)) * HTB)
#define G_SB(b, h) ((4 + (b) * 2 + (h)) * HTB)
#define G_STAGE2(bufoff, gbase, voff, kb) do { if constexpr (MODE != 3) _Pragma("unroll") for (int _i = 0; _i < 2; ++_i) \
        __builtin_amdgcn_global_load_lds((const unsigned*)((const char*)(gbase) + (unsigned)((voff)[_i] + (unsigned)(kb))), (LAS unsigned*)(lds + (bufoff) + ldsw + _i * 8192), 16, 0, 0); } while (0)
#define G_STAGE1(bufoff, gbase, voff, p1) do { if constexpr (MODE != 3) _Pragma("unroll") for (int _i = 0; _i < 2; ++_i) \
        __builtin_amdgcn_global_load_lds((const unsigned*)((const char*)(gbase) + _i * (p1) + (voff)), (LAS unsigned*)(lds + (bufoff) + ldsw + _i * 8192), 16, 0, 0); } while (0)
#define G_STAGE(bufoff, gbase, voff) G_STAGE1(bufoff, gbase, voff, p1B)
#define G_LDA(dst, b, h) do { _Pragma("unroll") for (int m = 0; m < 4; ++m) { if constexpr (P::F8) { const u32x4 lo_ = *(const LAS u32x4*)(lds + G_SA(b, h) + aoff + m * 2048), hi_ = *(const LAS u32x4*)(lds + G_SA(b, h) + aoff2 + m * 2048); dst.v[m] = (v8i_t){(int)lo_.x, (int)lo_.y, (int)lo_.z, (int)lo_.w, (int)hi_.x, (int)hi_.y, (int)hi_.z, (int)hi_.w}; } \
        else { _Pragma("unroll") for (int k = 0; k < 2; ++k) dst.v[m][k] = *(const LAS u32x4*)(lds + G_SA(b, h) + aoff + m * 2048 + k * 1024); } } } while (0)
#define G_LDB(dst, b, h) do { _Pragma("unroll") for (int n = 0; n < 2; ++n) { if constexpr (P::F8) { const u32x4 lo_ = *(const LAS u32x4*)(lds + G_SB(b, h) + boff + n * 2048), hi_ = *(const LAS u32x4*)(lds + G_SB(b, h) + boff2 + n * 2048); dst.v[n] = (v8i_t){(int)lo_.x, (int)lo_.y, (int)lo_.z, (int)lo_.w, (int)hi_.x, (int)hi_.y, (int)hi_.z, (int)hi_.w}; } \
        else { _Pragma("unroll") for (int k = 0; k < 2; ++k) dst.v[n][k] = *(const LAS u32x4*)(lds + G_SB(b, h) + boff + n * 2048 + k * 1024); } } } while (0)
#define G_MMA(ai, bj, At, Bt) do { if constexpr (MODE == 2) { _Pragma("unroll") for (int m = 0; m < 4; ++m) asm volatile("" :: "v"(At.v[m])); _Pragma("unroll") for (int n = 0; n < 2; ++n) asm volatile("" :: "v"(Bt.v[n])); } else { __builtin_amdgcn_s_setprio(1); _Pragma("unroll") for (int m = 0; m < 4; ++m) _Pragma("unroll") for (int n = 0; n < 2; ++n) { \
        if constexpr (P::F8) acc[ai][bj][m][n] = __builtin_amdgcn_mfma_scale_f32_16x16x128_f8f6f4(Bt.v[n], At.v[m], acc[ai][bj][m][n], 0, 0, 0, 0, 0, 0); \
        else { _Pragma("unroll") for (int k = 0; k < 2; ++k) acc[ai][bj][m][n] = __builtin_amdgcn_mfma_f32_16x16x32_bf16(__builtin_bit_cast(bf16x8, Bt.v[n][k]), __builtin_bit_cast(bf16x8, At.v[m][k]), acc[ai][bj][m][n], 0, 0, 0); } } \
        if constexpr (P::F8) { _Pragma("unroll") for (int m = 0; m < 4; ++m) _Pragma("unroll") for (int n = 0; n < 2; ++n) asm volatile("" : "+v"(acc[ai][bj][m][n])); } \
        __builtin_amdgcn_s_setprio(0); } } while (0)
#define G_WAIT_V(n) asm volatile("s_waitcnt vmcnt(" #n ")" ::: "memory")
#define G_WAIT_L(n) asm volatile("s_waitcnt lgkmcnt(" #n ")" ::: "memory")
#define G_BAR __builtin_amdgcn_s_barrier()
#define G_SCHED __builtin_amdgcn_sched_barrier(0)
    Unit cur, nxt; int ui = 0;
    if (!p.next(0, cur)) return;
    f32x4 acc[2][2][4][2];
#pragma unroll
    for (int a = 0; a < 2; ++a)
#pragma unroll
        for (int b = 0; b < 2; ++b)
#pragma unroll
            for (int m = 0; m < 4; ++m)
#pragma unroll
                for (int n = 0; n < 2; ++n) acc[a][b][m][n] = (f32x4){0.f, 0.f, 0.f, 0.f};
    FragA<P::F8> At; FragB<P::F8> B0, B1;
    unsigned ao_cur[2][2], ao_nxt[2][2], voffA = 0;
    const char* pA_cur = p.a_unit(cur); const char* pA_nxt = pA_cur;
    const size_t hstepA = (size_t)HALF * p.a_row_bytes();
    if constexpr (P::GATHER) { p.idx_issue(cur.pm, cur.kind, 0, wid); G_WAIT_V(0); G_BAR; p.a_off(cur, 0, ao_cur); }
    else { int R, C; if constexpr (P::F8) { R = tid >> 3; C = 8 * ((tid & 7) ^ g8(R & 15)); } else stage_rc(tid * 16, R, C); voffA = (unsigned)(R * p.a_row_bytes() + C * 2); }
    const size_t p1A = (size_t)64 * p.a_row_bytes();
#define G_STAGE_A(bufoff, U, h, kb) do { if constexpr (P::GATHER) G_STAGE2(bufoff, pA_cur, ao_##U[h], kb); else G_STAGE1(bufoff, pA_##U + (h) * hstepA + (kb), voffA, p1A); } while (0)
    const char* cB = p.b_ptr(cur);
    G_STAGE(G_SB(0, 0), cB, voffB); G_STAGE_A(G_SA(0, 0), cur, 0, 0); G_STAGE(G_SB(0, 1), cB + hstep, voffB); G_STAGE_A(G_SA(0, 1), cur, 1, 0);
    if (wr == 1) G_BAR;
    G_WAIT_V(4); G_BAR;
    G_STAGE(G_SB(1, 0), cB + kstep, voffB); G_STAGE_A(G_SA(1, 0), cur, 0, kstep); G_STAGE(G_SB(1, 1), cB + hstep + kstep, voffB);
    if constexpr (DS) { G_STAGE_A(G_SA(1, 1), cur, 1, kstep); E.pf_issue(cur.pm, cur.kind, 0, wr, wc); G_WAIT_V(0); G_BAR; }
    else { G_WAIT_V(6); G_BAR; }
#define G_TRIP(K1, U2, K2, B2) do { \
            G_LDB(B0, 0, 0); G_SCHED; G_LDA(At, 0, 0); G_STAGE_A(G_SA(1, 1), cur, 1, (K1)); \
            G_WAIT_L(8); G_BAR; G_WAIT_L(0); G_MMA(0, 0, At, B0); G_BAR; G_SCHED; \
            G_LDB(B1, 0, 1); G_STAGE(G_SB(0, 0), (B2), voffB); \
            G_BAR; G_WAIT_L(0); G_MMA(0, 1, At, B1); G_BAR; \
            G_LDA(At, 0, 1); G_STAGE_A(G_SA(0, 0), U2, 0, (K2)); \
            G_BAR; G_WAIT_L(0); G_MMA(1, 0, At, B0); G_BAR; G_SCHED; \
            G_STAGE(G_SB(0, 1), (B2) + hstep, voffB); \
            G_WAIT_V(6); G_BAR; G_MMA(1, 1, At, B1); G_BAR; \
            G_LDB(B0, 1, 0); G_SCHED; G_LDA(At, 1, 0); G_STAGE_A(G_SA(0, 1), U2, 1, (K2)); \
            G_WAIT_L(8); G_BAR; G_WAIT_L(0); G_MMA(0, 0, At, B0); G_BAR; G_SCHED; \
            G_LDB(B1, 1, 1); G_STAGE(G_SB(1, 0), (B2) + kstep, voffB); \
            G_BAR; G_WAIT_L(0); G_MMA(0, 1, At, B1); G_BAR; \
            G_LDA(At, 1, 1); G_STAGE_A(G_SA(1, 0), U2, 0, (K2) + kstep); \
            G_BAR; G_WAIT_L(0); G_MMA(1, 0, At, B0); G_BAR; G_SCHED; \
            G_STAGE(G_SB(1, 1), (B2) + kstep + hstep, voffB); \
            G_WAIT_V(6); G_BAR; G_MMA(1, 1, At, B1); G_BAR; } while (0)
#define G_TRIP_D(B2) do { \
            G_LDB(B0, 0, 0); G_SCHED; G_LDA(At, 0, 0); \
            G_WAIT_L(8); G_BAR; G_WAIT_L(0); G_MMA(0, 0, At, B0); G_BAR; G_SCHED; \
            G_LDB(B1, 0, 1); G_STAGE(G_SB(0, 0), (B2), voffB); \
            G_BAR; G_WAIT_L(0); G_MMA(0, 1, At, B1); G_BAR; \
            G_LDA(At, 0, 1); G_STAGE_A(G_SA(0, 0), nxt, 0, (size_t)0); \
            G_BAR; G_WAIT_L(0); G_MMA(1, 0, At, B0); G_BAR; G_SCHED; \
            G_STAGE(G_SB(0, 1), (B2) + hstep, voffB); \
            G_WAIT_V(15); G_BAR; G_MMA(1, 1, At, B1); G_BAR; \
            G_LDB(B0, 1, 0); G_SCHED; G_LDA(At, 1, 0); G_STAGE_A(G_SA(0, 1), nxt, 1, (size_t)0); \
            G_WAIT_L(8); G_BAR; G_WAIT_L(0); G_MMA(0, 0, At, B0); G_BAR; G_SCHED; \
            G_LDB(B1, 1, 1); G_STAGE(G_SB(1, 0), (B2) + kstep, voffB); \
            G_BAR; G_WAIT_L(0); G_MMA(0, 1, At, B1); G_BAR; \
            G_LDA(At, 1, 1); G_STAGE_A(G_SA(1, 0), nxt, 0, kstep); \
            G_BAR; G_WAIT_L(0); G_MMA(1, 0, At, B0); G_BAR; G_SCHED; \
            G_STAGE(G_SB(1, 1), (B2) + kstep + hstep, voffB); \
            G_BAR; G_MMA(1, 1, At, B1); G_BAR; \
            G_STAGE_A(G_SA(1, 1), nxt, 1, kstep); } while (0)
    for (;;) {
        const bool has_next = p.next(ui + 1, nxt);
        if constexpr (P::GATHER) p.idx_issue(has_next ? nxt.pm : cur.pm, has_next ? nxt.kind : cur.kind, (ui + 1) & 1, wid);
        for (int t = 0; t < nt - 2; t += 2) {
            const size_t k1 = (size_t)(t + 1) * kstep;
            G_TRIP(k1, cur, k1 + kstep, cB + k1 + kstep);
        }
        const char* nB = cB;
        if (has_next) { if constexpr (P::GATHER) p.a_off(nxt, (ui + 1) & 1, ao_nxt); else pA_nxt = p.a_unit(nxt); nB = p.b_ptr(nxt); }
        else { if constexpr (P::GATHER) {
#pragma unroll
            for (int h = 0; h < 2; ++h)
#pragma unroll
                for (int i = 0; i < 2; ++i) ao_nxt[h][i] = ao_cur[h][i]; } else pA_nxt = pA_cur; }
        if constexpr (DS) { E.pf_issue(has_next ? nxt.pm : cur.pm, has_next ? nxt.kind : cur.kind, (ui + 1) & 1, wr, wc); G_TRIP_D(nB); }
        else G_TRIP((size_t)(nt - 1) * kstep, nxt, (size_t)0, nB);
        if (wr == 0) G_BAR;
        { int tz = threadIdx.x; asm volatile("" : "+v"(tz)); const int l2 = tz & 63; if constexpr (MODE == 0) { if constexpr (DS) E(acc, cur, wr, wc, l2 & 15, l2 >> 4, ui & 1); else E(acc, cur, wr, wc, l2 & 15, l2 >> 4); } else { _Pragma("unroll") for (int a_ = 0; a_ < 2; ++a_) _Pragma("unroll") for (int b_ = 0; b_ < 2; ++b_) _Pragma("unroll") for (int m_ = 0; m_ < 4; ++m_) _Pragma("unroll") for (int n_ = 0; n_ < 2; ++n_) asm volatile("" :: "v"(acc[a_][b_][m_][n_])); } }
        if (!has_next) break;
        if constexpr (DS) { G_WAIT_V(16); G_BAR; }
        if (wr == 1) G_BAR;
#pragma unroll
        for (int a = 0; a < 2; ++a)
#pragma unroll
            for (int b = 0; b < 2; ++b)
#pragma unroll
                for (int m = 0; m < 4; ++m)
#pragma unroll
                    for (int n = 0; n < 2; ++n) acc[a][b][m][n] = (f32x4){0.f, 0.f, 0.f, 0.f};
        if constexpr (P::GATHER) {
#pragma unroll
            for (int h = 0; h < 2; ++h)
#pragma unroll
                for (int i = 0; i < 2; ++i) ao_cur[h][i] = ao_nxt[h][i]; } else pA_cur = pA_nxt;
        cur = nxt; cB = nB; ++ui;
    }
    G_WAIT_V(0);
    G_BAR;
#undef G_TRIP
#undef G_TRIP_D
#undef G_STAGE_A
#undef G_SA
#undef G_SB
#undef G_STAGE
#undef G_STAGE1
#undef G_STAGE2
#undef G_LDA
#undef G_LDB
#undef G_MMA
}

typedef f32x4 Acc[2][2][4][2];

struct EpiF32 {
    static constexpr bool PERM = false;
    float* C; int ldc;
    __device__ __forceinline__ void operator()(const Acc& acc, const Unit& u, int wr, int wc, int fr, int fq) const {
        const int row0 = u.pm * BM + wr * 64 + fr, col0 = u.pn * BM + wc * 32 + 4 * fq;
#pragma unroll
        for (int ai = 0; ai < 2; ++ai)
#pragma unroll
            for (int m = 0; m < 4; ++m) { float* rowp = C + (size_t)(row0 + ai * HALF + m * 16) * ldc + col0;
#pragma unroll
                for (int bj = 0; bj < 2; ++bj)
#pragma unroll
                    for (int n = 0; n < 2; ++n) *(f32x4*)(rowp + bj * HALF + n * 16) = acc[ai][bj][m][n]; }
    }
};
struct EpiBf16Bias {
    static constexpr bool PERM = true;
    bf16_t* O; int ldc; const float* bias;
    __device__ __forceinline__ void operator()(const Acc& acc, const Unit& u, int wr, int wc, int fr, int fq) const {
        const int row0 = u.pm * BM + wr * 64 + fr, col0 = u.pn * BM + wc * 32 + 8 * fq;
        f32x4 bv[2][2];
#pragma unroll
        for (int bj = 0; bj < 2; ++bj)
#pragma unroll
            for (int n = 0; n < 2; ++n) bv[bj][n] = *(const f32x4*)(bias + col0 + bj * HALF + 4 * n);
#pragma unroll
        for (int ai = 0; ai < 2; ++ai)
#pragma unroll
            for (int m = 0; m < 4; ++m) { bf16_t* rowp = O + (size_t)(row0 + ai * HALF + m * 16) * ldc + col0;
#pragma unroll
                for (int bj = 0; bj < 2; ++bj) { const f32x4 v0 = acc[ai][bj][m][0] + bv[bj][0], v1 = acc[ai][bj][m][1] + bv[bj][1];
                    u32x4 w; w.x = pk_bf16(v0[0], v0[1]); w.y = pk_bf16(v0[2], v0[3]); w.z = pk_bf16(v1[0], v1[1]); w.w = pk_bf16(v1[2], v1[3]);
                    *(u32x4*)(rowp + bj * HALF) = w; } }
    }
};
struct EpiInProj {
    static constexpr bool PERM = true;
    bf16_t* qkv; bf16_t* abuf; const float* rope;
    __device__ __forceinline__ void operator()(const Acc& acc, const Unit& u, int wr, int wc, int fr, int fq) const {
        const int row0 = u.pm * BM + wr * 64 + fr;
        if (u.pn < 6) {
            const int which = u.pn >> 1;
            const bool rot = (which < 2) && ((wc & 1) == 0);
            const float qs = (which == 0) ? 0.125f : 1.0f;
            bf16_t* dst = qkv + (size_t)which * NT * AW;
            const float sg = (fq == 0) ? -1.0f : 1.0f;
            f32x4 ra[4], rb[4];
#define IP_LOAD(dst_, g) do { const float* rp_ = rope + (size_t)(row0 + ((g) >> 2) * HALF + ((g) & 3) * 16) * 16; _Pragma("unroll") for (int j_ = 0; j_ < 4; ++j_) dst_[j_] = *(const f32x4*)(rp_ + 4 * j_); } while (0)
#define IP_GROUP(ROT, cs_, g) do { const int ai = (g) >> 2, m = (g) & 3; const int row = row0 + ai * HALF + m * 16, b = row >> 13, s = row & (SEQ - 1); \
                _Pragma("unroll") for (int bj = 0; bj < 2; ++bj) { float v[8]; \
                    _Pragma("unroll") for (int j = 0; j < 4; ++j) { v[j] = acc[ai][bj][m][0][j]; v[4 + j] = acc[ai][bj][m][1][j]; } \
                    if (ROT) { _Pragma("unroll") for (int j = 0; j < 8; ++j) { const float pv = __shfl_xor(v[j], 16); const float r = v[j] * cs_[j >> 2][j & 3] + sg * pv * cs_[2 + (j >> 2)][j & 3]; v[j] = (fq < 2) ? r : v[j]; } } \
                    const int head = (u.pn & 1) * 4 + 2 * bj + (wc >> 1), colh = 32 * (wc & 1) + 8 * fq; \
                    u32x4 w; w.x = pk_bf16(v[0] * qs, v[1] * qs); w.y = pk_bf16(v[2] * qs, v[3] * qs); w.z = pk_bf16(v[4] * qs, v[5] * qs); w.w = pk_bf16(v[6] * qs, v[7] * qs); \
                    *(u32x4*)(dst + ((size_t)(b * NHEAD + head) * SEQ + s) * HD + colh) = w; } } while (0)
            if (rot) {
                IP_LOAD(ra, 0);
#pragma unroll
                for (int g = 0; g < 8; g += 2) {
                    IP_LOAD(rb, g + 1);
                    asm volatile("" ::: "memory");
                    IP_GROUP(true, ra, g);
                    if (g + 2 < 8) IP_LOAD(ra, g + 2);
                    asm volatile("" ::: "memory");
                    IP_GROUP(true, rb, g + 1);
                }
            } else {
#pragma unroll
                for (int g = 0; g < 8; ++g) IP_GROUP(false, ra, g);
            }
#undef IP_LOAD
#undef IP_GROUP
        } else {
            const int ch0 = (u.pn - 6) * 128 + wc * 32 + 8 * fq;
#pragma unroll
            for (int ai = 0; ai < 2; ++ai)
#pragma unroll
                for (int m = 0; m < 4; ++m) {
                    const int row = row0 + ai * HALF + m * 16;
                    float v[8];
#pragma unroll
                    for (int j = 0; j < 4; ++j) { v[j] = acc[ai][0][m][0][j] * sigmoid_fast(acc[ai][1][m][0][j]); v[4 + j] = acc[ai][0][m][1][j] * sigmoid_fast(acc[ai][1][m][1][j]); }
                    u32x4 w; w.x = pk_bf16(v[0], v[1]); w.y = pk_bf16(v[2], v[3]); w.z = pk_bf16(v[4], v[5]); w.w = pk_bf16(v[6], v[7]);
                    *(u32x4*)(abuf + (size_t)row * CW + ch0) = w;
                }
        }
    }
};
struct EpiOut {
    static constexpr bool PERM = true;
    const float* __restrict__ x; bf16_t* __restrict__ x1; const float* __restrict__ gate;
    __device__ __forceinline__ void operator()(const Acc& acc, const Unit& u, int wr, int wc, int fr, int fq) const {
        const int row0 = u.pm * BM + wr * 64 + fr, col0 = u.pn * BM + wc * 32 + 8 * fq;
        const int b = (u.pm * BM) >> 13;
        f32x4 gv[2][2];
#pragma unroll
        for (int bj = 0; bj < 2; ++bj)
#pragma unroll
            for (int n = 0; n < 2; ++n) gv[bj][n] = *(const f32x4*)(gate + (size_t)b * 6144 + col0 + bj * HALF + n * 4);
        f32x4 xa[2][2], xb[2][2];
#define EO_LOAD(dst, g) do { const size_t off_ = (size_t)(row0 + ((g) >> 2) * HALF + ((g) & 3) * 16) * DM + col0; _Pragma("unroll") for (int bj = 0; bj < 2; ++bj) _Pragma("unroll") for (int n = 0; n < 2; ++n) dst[bj][n] = *(const f32x4*)(x + off_ + bj * HALF + n * 4); } while (0)
#define EO_STORE(srcv, g) do { const size_t off_ = (size_t)(row0 + ((g) >> 2) * HALF + ((g) & 3) * 16) * DM + col0; _Pragma("unroll") for (int bj = 0; bj < 2; ++bj) { \
            const f32x4 v0 = srcv[bj][0] + gv[bj][0] * acc[(g) >> 2][bj][(g) & 3][0], v1 = srcv[bj][1] + gv[bj][1] * acc[(g) >> 2][bj][(g) & 3][1]; \
            u32x4 w; w.x = pk_bf16(v0[0], v0[1]); w.y = pk_bf16(v0[2], v0[3]); w.z = pk_bf16(v1[0], v1[1]); w.w = pk_bf16(v1[2], v1[3]); *(u32x4*)(x1 + off_ + bj * HALF) = w; } } while (0)
        EO_LOAD(xa, 0);
#pragma unroll
        for (int g = 0; g < 8; g += 2) {
            EO_LOAD(xb, g + 1);
            asm volatile("" ::: "memory");
            EO_STORE(xa, g);
            if (g + 2 < 8) EO_LOAD(xa, g + 2);
            asm volatile("" ::: "memory");
            EO_STORE(xb, g + 1);
        }
#undef EO_LOAD
#undef EO_STORE
    }
};
typedef float f32x2_t __attribute__((ext_vector_type(2)));
__device__ __forceinline__ f32x4 load_sc1_x4(const float* p) { f32x4 v; asm volatile("global_load_dwordx4 %0, %1, off sc1\n\ts_waitcnt vmcnt(0)" : "=&v"(v) : "v"(p) : "memory"); return v; }
__device__ __forceinline__ f32x2_t load_sc1_x2(const float* p) { f32x2_t v; asm volatile("global_load_dwordx2 %0, %1, off sc1\n\ts_waitcnt vmcnt(0)" : "=&v"(v) : "v"(p) : "memory"); return v; }
struct EpiOutNorm {
    static constexpr bool PERM = true;
    const float* __restrict__ x; bf16_t* __restrict__ x1; const float* __restrict__ ada; const float* __restrict__ g2;
    bf16_t* __restrict__ h2; unsigned char* __restrict__ h28; float* xb; unsigned* cnt; LAS unsigned char* lx;
    __device__ __forceinline__ void operator()(Acc& acc, const Unit& u, int wr, int wc, int fr, int fq) const {
        const int row0 = u.pm * BM + wr * 64 + fr, col0 = u.pn * BM + wc * 32 + 8 * fq;
        const float* adab = ada + (size_t)((u.pm * BM) >> 13) * 6144;
        float ps[8];
        {
            f32x4 gv[2][2];
#pragma unroll
            for (int bj = 0; bj < 2; ++bj)
#pragma unroll
                for (int n = 0; n < 2; ++n) gv[bj][n] = *(const f32x4*)(adab + 2048 + col0 + bj * HALF + n * 4);
            f32x4 xa[2][2], xb2[2][2];
#define EN_LOAD(dst, g) do { const unsigned off_ = (unsigned)((row0 + ((g) >> 2) * HALF + ((g) & 3) * 16) * DM + col0); _Pragma("unroll") for (int bj = 0; bj < 2; ++bj) _Pragma("unroll") for (int n = 0; n < 2; ++n) dst[bj][n] = *(const f32x4*)((const char*)x + (off_ + bj * HALF + n * 4) * 4u); } while (0)
#define EN_STORE(srcv, g) do { const unsigned off_ = (unsigned)((row0 + ((g) >> 2) * HALF + ((g) & 3) * 16) * DM + col0); float s_ = 0.f; _Pragma("unroll") for (int bj = 0; bj < 2; ++bj) { \
                const f32x4 v0 = srcv[bj][0] + gv[bj][0] * acc[(g) >> 2][bj][(g) & 3][0], v1 = srcv[bj][1] + gv[bj][1] * acc[(g) >> 2][bj][(g) & 3][1]; \
                acc[(g) >> 2][bj][(g) & 3][0] = v0; acc[(g) >> 2][bj][(g) & 3][1] = v1; \
                s_ += (v0[0] * v0[0] + v0[1] * v0[1]) + (v0[2] * v0[2] + v0[3] * v0[3]) + (v1[0] * v1[0] + v1[1] * v1[1]) + (v1[2] * v1[2] + v1[3] * v1[3]); \
                u32x4 w; w.x = pk_bf16(v0[0], v0[1]); w.y = pk_bf16(v0[2], v0[3]); w.z = pk_bf16(v1[0], v1[1]); w.w = pk_bf16(v1[2], v1[3]); *(u32x4*)((char*)x1 + (off_ + bj * HALF) * 2u) = w; } ps[g] = s_; } while (0)
            EN_LOAD(xa, 0);
#pragma unroll
            for (int g = 0; g < 8; g += 2) {
                EN_LOAD(xb2, g + 1);
                asm volatile("" ::: "memory");
                EN_STORE(xa, g);
                if (g + 2 < 8) EN_LOAD(xa, g + 2);
                asm volatile("" ::: "memory");
                EN_STORE(xb2, g + 1);
            }
#undef EN_LOAD
#undef EN_STORE
        }
#pragma unroll
        for (int g = 0; g < 8; ++g) { ps[g] += __shfl_xor(ps[g], 16); ps[g] += __shfl_xor(ps[g], 32); }
        LAS float* P = (LAS float*)lx; LAS float* S = P + 1024;
        if (fq == 0) {
#pragma unroll
            for (int g = 0; g < 8; ++g) P[((g >> 2) * HALF + wr * 64 + (g & 3) * 16 + fr) * 4 + wc] = ps[g]; }
        asm volatile("s_waitcnt lgkmcnt(0)" ::: "memory"); __builtin_amdgcn_s_barrier(); asm volatile("" ::: "memory");
        const int w = wr * 4 + wc, lane = fq * 16 + fr, prow = 32 * w + (lane & 31);
        float* slot = xb + ((size_t)(u.e * 128 + u.pm) * 256 + prow) * 4;
        unsigned* c = cnt + (size_t)(u.e * 128 + u.pm) * 64;
        if (lane < 32) { const float t = (P[prow * 4 + 0] + P[prow * 4 + 1]) + (P[prow * 4 + 2] + P[prow * 4 + 3]);
            __hip_atomic_store(slot + u.pn, t, __ATOMIC_RELAXED, __HIP_MEMORY_SCOPE_AGENT); }
        asm volatile("s_waitcnt vmcnt(0)" ::: "memory");
        if (lane == 0) __hip_atomic_fetch_add(c, 1u, __ATOMIC_RELAXED, __HIP_MEMORY_SCOPE_AGENT);
        if (w == 0) {
            unsigned spins = 0;
            while ((unsigned)__builtin_amdgcn_readfirstlane(__hip_atomic_load(c, __ATOMIC_RELAXED, __HIP_MEMORY_SCOPE_AGENT)) < 32u) { __builtin_amdgcn_s_sleep(2); if (++spins > (1u << 22)) break; }
            __builtin_amdgcn_fence(__ATOMIC_ACQUIRE, "agent");
            asm volatile("s_waitcnt vmcnt(0)" ::: "memory");
        }
        asm volatile("s_waitcnt lgkmcnt(0)" ::: "memory"); __builtin_amdgcn_s_barrier(); asm volatile("" ::: "memory");
        if (lane < 32) { const f32x4 s4 = load_sc1_x4(slot); const float t = (s4[0] + s4[1]) + (s4[2] + s4[3]);
            S[prow] = rsqrtf(t * (1.0f / DM) + NORM_EPS); }
        asm volatile("s_waitcnt lgkmcnt(0)" ::: "memory"); __builtin_amdgcn_s_barrier(); asm volatile("" ::: "memory");
#pragma unroll
        for (int bj = 0; bj < 2; ++bj) {
            f32x4 gm[2], sh[2];
#pragma unroll
            for (int n = 0; n < 2; ++n) { const int cc = col0 + bj * HALF + n * 4; gm[n] = *(const f32x4*)(g2 + cc) * (*(const f32x4*)(adab + 4096 + cc) + 1.0f); sh[n] = *(const f32x4*)(adab + 3072 + cc); }
#pragma unroll
            for (int g = 0; g < 8; ++g) { const int rl = (g >> 2) * HALF + wr * 64 + (g & 3) * 16 + fr; const float rs = S[rl];
                const f32x4 y0 = acc[g >> 2][bj][g & 3][0] * rs * gm[0] + sh[0], y1 = acc[g >> 2][bj][g & 3][1] * rs * gm[1] + sh[1];
                const unsigned off_ = (unsigned)((u.pm * BM + rl) * DM + col0 + bj * HALF);
                u32x4 wv; wv.x = pk_bf16(y0[0], y0[1]); wv.y = pk_bf16(y0[2], y0[3]); wv.z = pk_bf16(y1[0], y1[1]); wv.w = pk_bf16(y1[2], y1[3]);
                *(u32x4*)((char*)h2 + off_ * 2u) = wv;
                u32x2 w8; w8.x = pk4_fp8(y0[0], y0[1], y0[2], y0[3]); w8.y = pk4_fp8(y1[0], y1[1], y1[2], y1[3]);
                *(u32x2*)(h28 + off_) = w8; }
        }
    }
};
struct EpiPw2Norm {
    static constexpr bool PERM = true;
    const float* __restrict__ bias; const float* __restrict__ gc; bf16_t* __restrict__ mix; float* xb; unsigned* cnt; LAS unsigned char* lx;
    __device__ __forceinline__ void operator()(Acc& acc, const Unit& u, int wr, int wc, int fr, int fq) const {
        const int col0 = u.pn * BM + wc * 32 + 8 * fq;
        float ps[8];
        {
            f32x4 bv[2][2];
#pragma unroll
            for (int bj = 0; bj < 2; ++bj)
#pragma unroll
                for (int n = 0; n < 2; ++n) bv[bj][n] = *(const f32x4*)(bias + col0 + bj * HALF + 4 * n);
#pragma unroll
            for (int g = 0; g < 8; ++g) { float s_ = 0.f;
#pragma unroll
                for (int bj = 0; bj < 2; ++bj)
#pragma unroll
                    for (int n = 0; n < 2; ++n) { const f32x4 v = acc[g >> 2][bj][g & 3][n] + bv[bj][n]; acc[g >> 2][bj][g & 3][n] = v; s_ += (v[0] * v[0] + v[1] * v[1]) + (v[2] * v[2] + v[3] * v[3]); }
                ps[g] = s_; }
        }
#pragma unroll
        for (int g = 0; g < 8; ++g) { ps[g] += __shfl_xor(ps[g], 16); ps[g] += __shfl_xor(ps[g], 32); }
        LAS float* P = (LAS float*)lx; LAS float* S = P + 1024;
        if (fq == 0) {
#pragma unroll
            for (int g = 0; g < 8; ++g) P[((g >> 2) * HALF + wr * 64 + (g & 3) * 16 + fr) * 4 + wc] = ps[g]; }
        asm volatile("s_waitcnt lgkmcnt(0)" ::: "memory"); __builtin_amdgcn_s_barrier(); asm volatile("" ::: "memory");
        const int w = wr * 4 + wc, lane = fq * 16 + fr, prow = 32 * w + (lane & 31);
        float* slot = xb + ((size_t)u.pm * 256 + prow) * 2;
        unsigned* c = cnt + (size_t)u.pm * 64;
        if (lane < 32) { const float t = (P[prow * 4 + 0] + P[prow * 4 + 1]) + (P[prow * 4 + 2] + P[prow * 4 + 3]);
            __hip_atomic_store(slot + u.pn, t, __ATOMIC_RELAXED, __HIP_MEMORY_SCOPE_AGENT); }
        asm volatile("s_waitcnt vmcnt(0)" ::: "memory");
        if (lane == 0) __hip_atomic_fetch_add(c, 1u, __ATOMIC_RELAXED, __HIP_MEMORY_SCOPE_AGENT);
        if (w == 0) {
            unsigned spins = 0;
            while ((unsigned)__builtin_amdgcn_readfirstlane(__hip_atomic_load(c, __ATOMIC_RELAXED, __HIP_MEMORY_SCOPE_AGENT)) < 16u) { __builtin_amdgcn_s_sleep(2); if (++spins > (1u << 22)) break; }
            __builtin_amdgcn_fence(__ATOMIC_ACQUIRE, "agent");
            asm volatile("s_waitcnt vmcnt(0)" ::: "memory");
        }
        asm volatile("s_waitcnt lgkmcnt(0)" ::: "memory"); __builtin_amdgcn_s_barrier(); asm volatile("" ::: "memory");
        if (lane < 32) { const f32x2_t s2 = load_sc1_x2(slot); const float t = s2[0] + s2[1];
            S[prow] = rsqrtf(t * (1.0f / CW) + NORM_EPS); }
        asm volatile("s_waitcnt lgkmcnt(0)" ::: "memory"); __builtin_amdgcn_s_barrier(); asm volatile("" ::: "memory");
#pragma unroll
        for (int bj = 0; bj < 2; ++bj) {
            f32x4 gm[2];
#pragma unroll
            for (int n = 0; n < 2; ++n) gm[n] = *(const f32x4*)(gc + col0 + bj * HALF + n * 4);
#pragma unroll
            for (int g = 0; g < 8; ++g) { const int rl = (g >> 2) * HALF + wr * 64 + (g & 3) * 16 + fr; const float rs = S[rl];
                const f32x4 y0 = acc[g >> 2][bj][g & 3][0] * rs * gm[0], y1 = acc[g >> 2][bj][g & 3][1] * rs * gm[1];
                u32x4 wv; wv.x = pk_bf16(y0[0], y0[1]); wv.y = pk_bf16(y0[2], y0[3]); wv.z = pk_bf16(y1[0], y1[1]); wv.w = pk_bf16(y1[2], y1[3]);
                *(u32x4*)((char*)mix + (unsigned)(((u.pm * BM + rl) * DM + AW + col0 + bj * HALF) * 2)) = wv; }
        }
    }
};
struct EpiGU {
    static constexpr bool PERM = true;
    unsigned char* H;
    __device__ __forceinline__ void operator()(const Acc& acc, const Unit& u, int wr, int wc, int fr, int fq) const {
        const int row0 = u.pm + wr * 64 + fr, col0 = u.pn * 128 + wc * 32 + 8 * fq;
#pragma unroll
        for (int ai = 0; ai < 2; ++ai)
#pragma unroll
            for (int m = 0; m < 4; ++m) {
                float v[8];
#pragma unroll
                for (int j = 0; j < 4; ++j) { v[j] = silu_fast(acc[ai][0][m][0][j] * F8_WINV) * (acc[ai][1][m][0][j] * F8_WINV); v[4 + j] = silu_fast(acc[ai][0][m][1][j] * F8_WINV) * (acc[ai][1][m][1][j] * F8_WINV); }
                u32x2 w; w.x = pk4_fp8(v[0], v[1], v[2], v[3]); w.y = pk4_fp8(v[4], v[5], v[6], v[7]);
                *(u32x2*)(H + (size_t)(row0 + ai * HALF + m * 16) * FE + col0) = w;
            }
    }
};
struct EpiDown {
    static constexpr bool PERM = true;
    static constexpr bool PF = true;
    unsigned char* Y; LAS unsigned char* xch; const int* aids;
    __device__ __forceinline__ void pf_issue(int upm, int ukind, int par, int wr, int wc) const {
        int tz = threadIdx.x; asm volatile("" : "+v"(tz)); const int lane = tz & 63;
        const int row = upm + (wc & 1) * HALF + wr * 64 + lane;
        __builtin_amdgcn_global_load_lds((const unsigned*)(aids + (ukind == 0 ? row : lane)), (LAS unsigned*)(xch + 4 * 4352 + par * 1024 + wr * 512 + (wc & 1) * 256), 4, 0, 0);
    }
    __device__ __forceinline__ void operator()(const Acc& acc, const Unit& u, int wr, int wc, int fr, int fq, int par) const {
        const float sc = 16.0f * F8_WINV;
        const int lt = threadIdx.x & 255, rrow = lt >> 4, rc16 = lt & 15;
        const int wbyte = fr * 272 + wc * 32 + 8 * fq;
        static_assert((WS_H2F8 - WS_YBUF) % 1024 == 0, "dummy rows must be row-aligned");
        constexpr int DR0 = (int)((WS_H2F8 - WS_YBUF) / 1024);
        const LAS int* ib = (const LAS int*)(xch + 4 * 4352 + par * 1024 + wr * 512);
        const bool k0 = u.kind == 0;
        unsigned char* gbase = Y + u.pn * BM + 16 * rc16;
#pragma unroll
        for (int g = 0; g < 8; ++g) {
            const int ai = g >> 2, m = g & 3;
            LAS unsigned char* buf = xch + (wr * 2 + (g & 1)) * 4352;
#pragma unroll
            for (int bj = 0; bj < 2; ++bj) { const f32x4 v0 = acc[ai][bj][m][0] * sc, v1 = acc[ai][bj][m][1] * sc;
                u32x2 w; w.x = pk4_fp8(v0[0], v0[1], v0[2], v0[3]); w.y = pk4_fp8(v1[0], v1[1], v1[2], v1[3]);
                *(LAS u32x2*)(buf + wbyte + bj * HALF) = w; }
            const int aid = ib[ai * 64 + m * 16 + rrow], slot = u.pm + ai * HALF + wr * 64 + m * 16 + rrow;
            asm volatile("s_waitcnt lgkmcnt(0)" ::: "memory"); __builtin_amdgcn_s_barrier(); asm volatile("" ::: "memory");
            const u32x4 o = *(const LAS u32x4*)(buf + rrow * 272 + 16 * rc16);
            const int ya = aid < 0 ? DR0 + (slot & (NT - 1)) : aid + (aid >> 3), yb = (slot - NSLOT_MAX) * 9 + 8;
            *(u32x4*)(gbase + (size_t)(k0 ? ya : yb) * DM) = o;
        }
    }
};

struct Args {
    const float* in[26];
    float* out;
    unsigned char* ws;
    int ph_lo, ph_hi;
};
constexpr int NPHASE = 14;

__device__ __forceinline__ void transpose_job(LAS unsigned* T, const float* srcA, const float* srcB, int ldsrc, bf16_t* dst, int lddst) {
    const int tid = threadIdx.x, lane = tid & 63, w = tid >> 6;
    const float* src = (lane < 32) ? (srcA + 4 * lane) : (srcB + 4 * (lane - 32));
    f32x4 v0[4], v1[4];
#pragma unroll
    for (int i = 0; i < 4; ++i) { const int k0 = 2 * w + 16 * i; v0[i] = *(const f32x4*)(src + (size_t)k0 * ldsrc); v1[i] = *(const f32x4*)(src + (size_t)(k0 + 1) * ldsrc); }
#pragma unroll
    for (int i = 0; i < 4; ++i)
#pragma unroll
        for (int j = 0; j < 4; ++j) T[(j * 64 + lane) * 33 + (w + 8 * i)] = pk_bf16(v0[i][j], v1[i][j]);
    __syncthreads();
#pragma unroll
    for (int q = 0; q < 4; ++q) { const int n = (tid >> 3) + 64 * q, kc = tid & 7, rho = (n & 3) * 64 + (n >> 2);
        u32x4 o; o.x = T[rho * 33 + kc * 4 + 0]; o.y = T[rho * 33 + kc * 4 + 1]; o.z = T[rho * 33 + kc * 4 + 2]; o.w = T[rho * 33 + kc * 4 + 3];
        *(u32x4*)(dst + (size_t)n * lddst + kc * 8) = o; }
    __syncthreads();
}
struct F8Job { const float* a; const float* b; int ld; unsigned char* dst; int ldd; };
__device__ __forceinline__ void f8job_load(const F8Job& J, f32x4 (&v)[4][4]) {
    const int lane = threadIdx.x & 63, w = threadIdx.x >> 6;
    const float* src = (lane < 32) ? (J.a + 4 * lane) : (J.b + 4 * (lane - 32));
#pragma unroll
    for (int i = 0; i < 4; ++i)
#pragma unroll
        for (int kk = 0; kk < 4; ++kk) v[i][kk] = *(const f32x4*)(src + (size_t)(4 * w + 32 * i + kk) * J.ld);
}
__device__ __forceinline__ void f8job_park(LAS unsigned* T, const f32x4 (&v)[4][4], float sc) {
    const int lane = threadIdx.x & 63, w = threadIdx.x >> 6;
#pragma unroll
    for (int i = 0; i < 4; ++i)
#pragma unroll
        for (int j = 0; j < 4; ++j) T[(j * 64 + lane) * 33 + (w + 8 * i)] = pk4_fp8(v[i][0][j] * sc, v[i][1][j] * sc, v[i][2][j] * sc, v[i][3][j] * sc);
}
__device__ __forceinline__ void f8job_store(const LAS unsigned* T, const F8Job& J) {
    const int tid = threadIdx.x;
#pragma unroll
    for (int q = 0; q < 4; ++q) { const int n = (tid >> 3) + 64 * q, kc = tid & 7, rho = (n & 3) * 64 + (n >> 2);
        u32x4 o; o.x = T[rho * 33 + kc * 4 + 0]; o.y = T[rho * 33 + kc * 4 + 1]; o.z = T[rho * 33 + kc * 4 + 2]; o.w = T[rho * 33 + kc * 4 + 3];
        *(u32x4*)(J.dst + (size_t)n * J.ldd + kc * 16) = o; }
}
constexpr int JOBS_GU = 257 * 16, JOBS_DN = 257 * 8, JOBS_F8 = JOBS_GU + JOBS_DN, JOBS_IN = 160, JOBS_OUT = 64, JOBS_PW2 = 16, JOBS_R = 16;
constexpr int JOBS_BF = JOBS_IN + JOBS_OUT + JOBS_PW2 + JOBS_R;

__device__ __forceinline__ void convert_f8_jobs(const Args& a, LAS unsigned char* lds, int jlo, int jhi, int k, int nk) {
    unsigned char* ws = a.ws; LAS unsigned* T = (LAS unsigned*)lds;
    const float* wg = a.in[19]; const float* wu = a.in[20]; const float* wd = a.in[21];
    const float* sg = a.in[22]; const float* su = a.in[23]; const float* sd = a.in[24];
    auto decode = [&](int j) -> F8Job { F8Job J;
        if (j < JOBS_GU) { const int e = j >> 4, r = j & 15, h = r >> 3, k0 = (r & 7) * 128;
            const float* ge = (e < NEXP) ? wg + (size_t)e * DM * FE : sg; const float* ue = (e < NEXP) ? wu + (size_t)e * DM * FE : su;
            J.a = ge + (size_t)k0 * FE + 128 * h; J.b = ue + (size_t)k0 * FE + 128 * h; J.ld = FE; J.dst = (unsigned char*)(ws + WS_WGU) + (size_t)(e * 2 + h) * 256 * DM + k0; J.ldd = DM;
        } else { const int jj = j - JOBS_GU, e = jj >> 3, r = jj & 7, n0 = (r >> 1) * 256, k0 = (r & 1) * 128;
            const float* de = (e < NEXP) ? wd + (size_t)e * FE * DM : sd;
            J.a = de + (size_t)k0 * DM + n0; J.b = J.a + 128; J.ld = DM; J.dst = (unsigned char*)(ws + WS_WDT) + ((size_t)e * DM + n0) * FE + k0; J.ldd = FE; }
        return J; };
    if (jlo + k < jhi) {
        f32x4 va[4][4], vb[4][4];
        F8Job ja = decode(jlo + k), jb = ja; f8job_load(ja, va);
        if (jlo + k + nk < jhi) { jb = decode(jlo + k + nk); f8job_load(jb, vb); }
        for (int j = jlo + k; j < jhi; j += 2 * nk) {
            { f8job_park(T, va, F8_WSCALE); const F8Job cur = ja; const int jn = j + 2 * nk; if (jn < jhi) { ja = decode(jn); f8job_load(ja, va); }
              __syncthreads(); f8job_store(T, cur); __syncthreads(); }
            if (j + nk < jhi) { f8job_park(T, vb, F8_WSCALE); const F8Job cur = jb; const int jn = j + 3 * nk; if (jn < jhi) { jb = decode(jn); f8job_load(jb, vb); }
              __syncthreads(); f8job_store(T, cur); __syncthreads(); }
        }
    }
}

__device__ __forceinline__ void p0_prologue(const Args& a, LAS unsigned char* lds) {
    const int tid = threadIdx.x, G = gridDim.x, bx = blockIdx.x;
    unsigned char* ws = a.ws;
    {
        LAS float* sl = (LAS float*)lds;
        LAS float* red = (LAS float*)(lds + 16384);
        const float* c = a.in[1]; const float* w_ada = a.in[4]; const float* b_ada = a.in[5];
        float* ada = (float*)(ws + WS_ADA);
        for (int i = tid; i < NB * DM; i += 512) sl[i] = silu_fast(c[i]);
        __syncthreads();
        for (int ci = bx; ci < 256; ci += G) {
            if (tid < 384) {
                const int q = tid % 6, ks = tid / 6, n = 24 * ci + 4 * q;
                f32x4 ac[4];
#pragma unroll
                for (int b = 0; b < 4; ++b) ac[b] = (f32x4){0.f, 0.f, 0.f, 0.f};
#pragma unroll 4
                for (int kk = 0; kk < 16; ++kk) { const int k = ks * 16 + kk; const f32x4 w4 = *(const f32x4*)(w_ada + (size_t)k * 6144 + n);
#pragma unroll
                    for (int b = 0; b < 4; ++b) ac[b] += w4 * sl[b * 1024 + k]; }
#pragma unroll
                for (int b = 0; b < 4; ++b)
#pragma unroll
                    for (int j = 0; j < 4; ++j) red[tid * 16 + b * 4 + j] = ac[b][j];
            }
            __syncthreads();
            if (tid < 96) { const int b = tid / 24, col = tid % 24, q = col >> 2, j = col & 3; float s = 0.f;
                for (int ks = 0; ks < 64; ++ks) s += red[(ks * 6 + q) * 16 + b * 4 + j];
                ada[(size_t)b * 6144 + 24 * ci + col] = s + b_ada[24 * ci + col]; }
            __syncthreads();
        }
    }
    {
        const int* pos = (const int*)a.in[2]; float* rope = (float*)(ws + WS_ROPE);
        for (int id = bx * 512 + tid; id < NT * 8; id += G * 512) { const int t = id >> 3, i = id & 7;
            const double invf = i == 0 ? 1.0 : i == 1 ? 0.19392274474868576 : i == 2 ? 0.03760603093086393 : i == 3 ? 0.007292664737217109
                              : i == 4 ? 0.001414213562373095 : i == 5 ? 0.0002742481756762073 : i == 6 ? 5.318295896944988e-05 : 1.031338537721246e-05;
            const double rev = (double)pos[t] * invf * 0.15915494309189535; const float fr = (float)(rev - __builtin_rint(rev));
            rope[(size_t)t * 16 + i] = __builtin_amdgcn_cosf(fr); rope[(size_t)t * 16 + 8 + i] = __builtin_amdgcn_sinf(fr); }
    }
    {
        LAS unsigned* T = (LAS unsigned*)lds;
        const float* w_in = a.in[6]; const float* w_pw2 = a.in[11]; const float* w_out = a.in[15]; const float* w_r = a.in[17];
        const float* wg = a.in[19]; const float* wu = a.in[20]; const float* wd = a.in[21];
        const float* sg = a.in[22]; const float* su = a.in[23]; const float* sd = a.in[24];
        for (int j = bx; j < JOBS_BF; j += G) {
            const float* sA; const float* sB; int ld; bf16_t* dst; int ldd;
            if (j < JOBS_IN) { const int pn = j >> 4, k0 = (j & 15) * 64;
                if (pn < 6) { sA = w_in + (size_t)k0 * NPROJ + 256 * pn; sB = sA + 128; }
                else { sA = w_in + (size_t)k0 * NPROJ + 1536 + 128 * (pn - 6); sB = w_in + (size_t)k0 * NPROJ + 2048 + 128 * (pn - 6); }
                ld = NPROJ; dst = (bf16_t*)(ws + WS_WIN) + (size_t)pn * 256 * DM + k0; ldd = DM;
            } else if (j < JOBS_IN + JOBS_OUT) { const int jj = j - JOBS_IN, pn = jj >> 4, k0 = (jj & 15) * 64;
                sA = w_out + (size_t)k0 * DM + 256 * pn; sB = sA + 128; ld = DM; dst = (bf16_t*)(ws + WS_WOUT) + (size_t)pn * 256 * DM + k0; ldd = DM;
            } else if (j < JOBS_IN + JOBS_OUT + JOBS_PW2) { const int jj = j - JOBS_IN - JOBS_OUT, pn = jj >> 3, k0 = (jj & 7) * 64;
                sA = w_pw2 + (size_t)k0 * CW + 256 * pn; sB = sA + 128; ld = CW; dst = (bf16_t*)(ws + WS_WPW2) + (size_t)pn * 256 * CW + k0; ldd = CW;
            } else { const int jj = j - JOBS_IN - JOBS_OUT - JOBS_PW2, k0 = jj * 64;
                sA = w_r + (size_t)k0 * NEXP; sB = sA + 128; ld = NEXP; dst = (bf16_t*)(ws + WS_WR) + k0; ldd = DM; }
            transpose_job(T, sA, sB, ld, dst, ldd);
        }
        if (G != 256) convert_f8_jobs(a, lds, 0, JOBS_F8, bx, G);
    }
}

__device__ __forceinline__ void normmod_phase(const float* X, const float* g, const float* sh, const float* sc, bf16_t* H) {
    const int lane = threadIdx.x & 63, wave = threadIdx.x >> 6;
    for (int row = blockIdx.x * 8 + wave; row < NT; row += gridDim.x * 8) {
        const int b = row >> 13;
        f32x4 xv[4]; float ss = 0.f;
#pragma unroll
        for (int j = 0; j < 4; ++j) { xv[j] = *(const f32x4*)(X + (size_t)row * DM + 4 * lane + 256 * j); ss += xv[j][0] * xv[j][0] + xv[j][1] * xv[j][1] + xv[j][2] * xv[j][2] + xv[j][3] * xv[j][3]; }
        ss = wave_sum(ss);
        const float rstd = rsqrtf(ss * (1.0f / DM) + NORM_EPS);
#pragma unroll
        for (int j = 0; j < 4; ++j) { const int col = 4 * lane + 256 * j;
            const f32x4 gv = *(const f32x4*)(g + col), sv = *(const f32x4*)(sc + (size_t)b * 6144 + col), hv = *(const f32x4*)(sh + (size_t)b * 6144 + col);
            const f32x4 y = (xv[j] * rstd) * gv * (sv + 1.0f) + hv;
            u32x2 w; w.x = pk_bf16(y[0], y[1]); w.y = pk_bf16(y[2], y[3]);
            *(u32x2*)(H + (size_t)row * DM + col) = w; }
    }
}

__device__ __forceinline__ void normmod_bf16_phase(const bf16_t* X, const float* g, const float* sh, const float* sc, bf16_t* H, unsigned char* H8) {
    const int lane = threadIdx.x & 63, wave = threadIdx.x >> 6;
    for (int row = blockIdx.x * 8 + wave; row < NT; row += gridDim.x * 8) {
        const int b = row >> 13;
        float v[2][8]; float ss = 0.f;
#pragma unroll
        for (int j = 0; j < 2; ++j) { const u32x4 w = *(const u32x4*)(X + (size_t)row * DM + 8 * lane + 512 * j);
            v[j][0] = bf_lo(w.x); v[j][1] = bf_hi(w.x); v[j][2] = bf_lo(w.y); v[j][3] = bf_hi(w.y); v[j][4] = bf_lo(w.z); v[j][5] = bf_hi(w.z); v[j][6] = bf_lo(w.w); v[j][7] = bf_hi(w.w);
#pragma unroll
            for (int i = 0; i < 8; ++i) ss += v[j][i] * v[j][i]; }
        ss = wave_sum(ss);
        const float rstd = rsqrtf(ss * (1.0f / DM) + NORM_EPS);
#pragma unroll
        for (int j = 0; j < 2; ++j) { const int col = 8 * lane + 512 * j; float y[8];
#pragma unroll
            for (int q = 0; q < 2; ++q) { const f32x4 gv = *(const f32x4*)(g + col + 4 * q), sv = *(const f32x4*)(sc + (size_t)b * 6144 + col + 4 * q), hv = *(const f32x4*)(sh + (size_t)b * 6144 + col + 4 * q);
#pragma unroll
                for (int i = 0; i < 4; ++i) y[4 * q + i] = (v[j][4 * q + i] * rstd) * gv[i] * (sv[i] + 1.0f) + hv[i]; }
            u32x4 w; w.x = pk_bf16(y[0], y[1]); w.y = pk_bf16(y[2], y[3]); w.z = pk_bf16(y[4], y[5]); w.w = pk_bf16(y[6], y[7]);
            *(u32x4*)(H + (size_t)row * DM + col) = w;
            u32x2 w8; w8.x = pk4_fp8(y[0], y[1], y[2], y[3]); w8.y = pk4_fp8(y[4], y[5], y[6], y[7]);
            *(u32x2*)(H8 + (size_t)row * DM + col) = w8; }
    }
}

__device__ __forceinline__ void attn_naive_unit(int unit, const bf16_t* Q, const bf16_t* Kb, const bf16_t* Vb, bf16_t* O, float* LSE) {
    const int lane = threadIdx.x & 63, head = threadIdx.x >> 6;
    const int t = unit * 64 + lane, b = t >> 13, s = t & (SEQ - 1);
    const size_t hb = (size_t)(b * NHEAD + head) * SEQ;
    float q[64];
    { const u32x4* qp = (const u32x4*)(Q + (hb + s) * HD);
#pragma unroll
      for (int c = 0; c < 8; ++c) { const u32x4 w = qp[c]; q[8 * c + 0] = bf_lo(w.x); q[8 * c + 1] = bf_hi(w.x); q[8 * c + 2] = bf_lo(w.y); q[8 * c + 3] = bf_hi(w.y); q[8 * c + 4] = bf_lo(w.z); q[8 * c + 5] = bf_hi(w.z); q[8 * c + 6] = bf_lo(w.w); q[8 * c + 7] = bf_hi(w.w); } }
    for (int br = 0; br < 3; ++br) {
        const int d = (br == 0) ? 1 : (br == 1 ? 4 : 16);
        float mx = -1e30f, l = 0.f; float o[64];
#pragma unroll
        for (int i = 0; i < 64; ++i) o[i] = 0.f;
        for (int j = 0; j <= 128; ++j) {
            const int p = s - j * d; if (p < 0) break;
            const u32x4* kp = (const u32x4*)(Kb + (hb + p) * HD);
            float sc = 0.f;
#pragma unroll
            for (int c = 0; c < 8; ++c) { const u32x4 w = kp[c];
                sc += q[8 * c + 0] * bf_lo(w.x) + q[8 * c + 1] * bf_hi(w.x) + q[8 * c + 2] * bf_lo(w.y) + q[8 * c + 3] * bf_hi(w.y) + q[8 * c + 4] * bf_lo(w.z) + q[8 * c + 5] * bf_hi(w.z) + q[8 * c + 6] * bf_lo(w.w) + q[8 * c + 7] * bf_hi(w.w); }
            const float mn = fmaxf(mx, sc), al = __expf(mx - mn), pe = __expf(sc - mn);
            l = l * al + pe; mx = mn;
            const u32x4* vp = (const u32x4*)(Vb + (hb + p) * HD);
#pragma unroll
            for (int c = 0; c < 8; ++c) { const u32x4 w = vp[c];
                o[8 * c + 0] = o[8 * c + 0] * al + pe * bf_lo(w.x); o[8 * c + 1] = o[8 * c + 1] * al + pe * bf_hi(w.x);
                o[8 * c + 2] = o[8 * c + 2] * al + pe * bf_lo(w.y); o[8 * c + 3] = o[8 * c + 3] * al + pe * bf_hi(w.y);
                o[8 * c + 4] = o[8 * c + 4] * al + pe * bf_lo(w.z); o[8 * c + 5] = o[8 * c + 5] * al + pe * bf_hi(w.z);
                o[8 * c + 6] = o[8 * c + 6] * al + pe * bf_lo(w.w); o[8 * c + 7] = o[8 * c + 7] * al + pe * bf_hi(w.w); }
        }
        const float inv = 1.0f / l;
        u32x4* op = (u32x4*)(O + ((size_t)br * NT + t) * AW + head * HD);
#pragma unroll
        for (int c = 0; c < 8; ++c) { u32x4 w; w.x = pk_bf16(o[8 * c + 0] * inv, o[8 * c + 1] * inv); w.y = pk_bf16(o[8 * c + 2] * inv, o[8 * c + 3] * inv); w.z = pk_bf16(o[8 * c + 4] * inv, o[8 * c + 5] * inv); w.w = pk_bf16(o[8 * c + 6] * inv, o[8 * c + 7] * inv); op[c] = w; }
        LSE[((size_t)br * NT + t) * NHEAD + head] = mx + __logf(l);
    }
}


typedef float f32x16 __attribute__((ext_vector_type(16)));
typedef short v4i16_t __attribute__((ext_vector_type(4)));
template <int AM = 0>
__device__ __forceinline__ void attn_unit(int unit, LAS unsigned char* lds, const bf16_t* Q, const bf16_t* Kb, const bf16_t* Vb, bf16_t* O, float* LSE) {
    const int tid = threadIdx.x, lane = tid & 63, w = __builtin_amdgcn_readfirstlane(tid >> 6), r32 = lane & 31, hi = lane >> 5;
    const int blk = unit & 31, rest = unit >> 5, br = rest % 3, bh = rest / 3;
    const int dsh = 2 * br, nper = 32 >> dsh, res = blk / nper, mblk = blk & (nper - 1), m0 = mblk * 256;
    const size_t hb = (size_t)bh * SEQ;
    u32x4 vst[6];
#pragma unroll
    for (int it = 0; it < 6; ++it) { const int cidx = tid + 512 * it, row = cidx >> 3, c = cidx & 7; int kidx = m0 - 128 + row; kidx = kidx < 0 ? 0 : kidx;
        vst[it] = *(const u32x4*)(Vb + (hb + ((size_t)kidx << dsh) + res) * HD + 8 * c); }
    const int qm = m0 + 32 * w + r32; const size_t qpos = ((size_t)qm << dsh) + res;
    bf16x8 qf[4];
#pragma unroll
    for (int s = 0; s < 4; ++s) qf[s] = *(const bf16x8*)(Q + (hb + qpos) * HD + 16 * s + 8 * hi);
    {
        u32x4 kst[6];
#pragma unroll
        for (int it = 0; it < 6; ++it) { const int cidx = tid + 512 * it, row = cidx >> 3, c = cidx & 7; int kidx = m0 - 128 + row; kidx = kidx < 0 ? 0 : kidx;
            kst[it] = *(const u32x4*)(Kb + (hb + ((size_t)kidx << dsh) + res) * HD + 8 * c); }
#pragma unroll
        for (int it = 0; it < 6; ++it) { const int cidx = tid + 512 * it, row = cidx >> 3, c = cidx & 7;
            *(LAS u32x4*)(lds + 49152 + row * 128 + 16 * (c ^ ((row >> 1) & 7))) = kst[it]; }
#pragma unroll
        for (int it = 0; it < 6; ++it) { const int cidx = tid + 512 * it, row = cidx >> 3, c = cidx & 7;
            *(LAS u32x4*)(lds + row * 128 + ((16 * c) ^ (((row >> 1) & 1) << 6))) = vst[it]; }
    }
    __syncthreads();
    f32x16 S[5];
    const int kswz = (r32 >> 1) & 7;
#pragma unroll
    for (int i = 0; i < 5; ++i) {
        const LAS unsigned char* kr = lds + 49152 + (32 * w + 32 * i + r32) * 128;
        bf16x8 kf[4];
#pragma unroll
        for (int s = 0; s < 4; ++s) kf[s] = *(const LAS bf16x8*)(kr + 16 * ((2 * s + hi) ^ kswz));
        f32x16 c = {0.f, 0.f, 0.f, 0.f, 0.f, 0.f, 0.f, 0.f, 0.f, 0.f, 0.f, 0.f, 0.f, 0.f, 0.f, 0.f};
#pragma unroll
        for (int s = 0; s < 4; ++s) c = __builtin_amdgcn_mfma_f32_32x32x16_bf16(kf[s], qf[s], c, 0, 0, 0);
        S[i] = c;
    }
    if constexpr (AM == 1) { _Pragma("unroll") for (int i = 0; i < 5; ++i) asm volatile("" :: "v"(S[i])); __syncthreads(); return; }
    float mx = -3e38f;
#pragma unroll
    for (int i = 0; i < 5; ++i) {
        const bool tile_ok = (mblk > 0) || (w + i >= 4);
#pragma unroll
        for (int r = 0; r < 16; ++r) { const int kl = (r & 3) + 8 * (r >> 2) + 4 * hi;
            bool ok = tile_ok; if (i == 0) ok = ok && (kl >= r32); if (i == 4) ok = ok && (kl <= r32);
            const float v = ok ? S[i][r] : -3e38f; S[i][r] = v; mx = fmaxf(mx, v); }
    }
    mx = fmaxf(mx, __shfl_xor(mx, 32));
    const float nm = -mx * 1.4426950408889634f;
    float l = 0.f;
#pragma unroll
    for (int i = 0; i < 5; ++i)
#pragma unroll
        for (int r = 0; r < 16; ++r) { const float p = __builtin_amdgcn_exp2f(__builtin_fmaf(S[i][r], 1.4426950408889634f, nm)); S[i][r] = p; l += p; }
    l += __shfl_xor(l, 32);
    if constexpr (AM == 2) { _Pragma("unroll") for (int i = 0; i < 5; ++i) asm volatile("" :: "v"(S[i])); asm volatile("" :: "v"(l), "v"(mx)); __syncthreads(); return; }
    f32x16 o0 = {0.f, 0.f, 0.f, 0.f, 0.f, 0.f, 0.f, 0.f, 0.f, 0.f, 0.f, 0.f, 0.f, 0.f, 0.f, 0.f}, o1 = o0;
    const int qq = (lane & 15) >> 2, pp = lane & 3, g1 = (lane >> 4) & 1;
    const int vb0 = (4 * hi + qq) * 128 + ((32 * g1 + 8 * pp) ^ (((qq >> 1) & 1) << 6)), vb1 = vb0 ^ 64;
#pragma unroll
    for (int i = 0; i < 5; ++i)
#pragma unroll
        for (int s2 = 0; s2 < 2; ++s2) {
            u32x4 pw; pw.x = pk_bf16(S[i][8 * s2 + 0], S[i][8 * s2 + 1]); pw.y = pk_bf16(S[i][8 * s2 + 2], S[i][8 * s2 + 3]); pw.z = pk_bf16(S[i][8 * s2 + 4], S[i][8 * s2 + 5]); pw.w = pk_bf16(S[i][8 * s2 + 6], S[i][8 * s2 + 7]);
            const bf16x8 pf = __builtin_bit_cast(bf16x8, pw);
            const int rowoff = (32 * w + 32 * i + 16 * s2) * 128;
            const v4i16_t a0 = __builtin_amdgcn_ds_read_tr16_b64_v4i16((LAS v4i16_t*)(lds + vb0 + rowoff)), a1 = __builtin_amdgcn_ds_read_tr16_b64_v4i16((LAS v4i16_t*)(lds + vb0 + rowoff + 1024));
            const v4i16_t b0 = __builtin_amdgcn_ds_read_tr16_b64_v4i16((LAS v4i16_t*)(lds + vb1 + rowoff)), b1 = __builtin_amdgcn_ds_read_tr16_b64_v4i16((LAS v4i16_t*)(lds + vb1 + rowoff + 1024));
            const bf16x8 vf0 = (bf16x8){a0[0], a0[1], a0[2], a0[3], a1[0], a1[1], a1[2], a1[3]}, vf1 = (bf16x8){b0[0], b0[1], b0[2], b0[3], b1[0], b1[1], b1[2], b1[3]};
            o0 = __builtin_amdgcn_mfma_f32_32x32x16_bf16(vf0, pf, o0, 0, 0, 0);
            o1 = __builtin_amdgcn_mfma_f32_32x32x16_bf16(vf1, pf, o1, 0, 0, 0);
        }
    if constexpr (AM == 3) { asm volatile("" :: "v"(o0), "v"(o1), "v"(l), "v"(mx)); __syncthreads(); return; }
    const float inv = 1.0f / l;
    const int head = bh & 7, b = bh >> 3; const size_t t = (size_t)b * SEQ + qpos;
    {
        LAS unsigned char* stg = lds + 98304 + w * 4352;
#pragma unroll
        for (int g = 0; g < 4; ++g) {
            u32x2 w0; w0.x = pk_bf16(o0[4 * g + 0] * inv, o0[4 * g + 1] * inv); w0.y = pk_bf16(o0[4 * g + 2] * inv, o0[4 * g + 3] * inv); *(LAS u32x2*)(stg + r32 * 136 + 2 * (8 * g + 4 * hi)) = w0;
            u32x2 w1; w1.x = pk_bf16(o1[4 * g + 0] * inv, o1[4 * g + 1] * inv); w1.y = pk_bf16(o1[4 * g + 2] * inv, o1[4 * g + 3] * inv); *(LAS u32x2*)(stg + r32 * 136 + 2 * (32 + 8 * g + 4 * hi)) = w1;
        }
        asm volatile("s_waitcnt lgkmcnt(0)" ::: "memory");
        const size_t tq0 = (size_t)b * SEQ + (((size_t)(m0 + 32 * w) << dsh) + res);
#pragma unroll
        for (int i = 0; i < 4; ++i) { const int rq = i * 8 + (lane >> 3), ch = lane & 7;
            const u32x2 lo = *(const LAS u32x2*)(stg + rq * 136 + 16 * ch), hi2 = *(const LAS u32x2*)(stg + rq * 136 + 16 * ch + 8);
            u32x4 ov; ov.x = lo.x; ov.y = lo.y; ov.z = hi2.x; ov.w = hi2.y;
            *(u32x4*)(O + ((size_t)br * NT + tq0 + ((size_t)rq << dsh)) * AW + head * HD + 8 * ch) = ov; }
    }
    if (hi == 0) LSE[((size_t)br * NT + t) * NHEAD + head] = mx + __logf(l);
    __syncthreads();
}

__device__ __forceinline__ void conv_unit(int unit, LAS unsigned char* lds, const bf16_t* Ab, const float* w_dw, const float* b_dw, const float* ln_g, const float* ln_b, bf16_t* Z) {
    const int tid = threadIdx.x, lane = tid & 63, wave = tid >> 6;
    const int t0 = unit * 32, s0 = t0 & (SEQ - 1);
    LAS float* Y = (LAS float*)lds;
    {
        const int c = tid;
        float wv[CONVK];
#pragma unroll
        for (int j = 0; j < CONVK; ++j) wv[j] = w_dw[j * CW + c];
        LAS unsigned char* Aw = lds + 65536;
        for (int r = wave; r < 62; r += 8) { const int s = s0 - 30 + r; const int tt = (s >= 0) ? (t0 - 30 + r) : (t0 - s0);
            __builtin_amdgcn_global_load_lds((const unsigned*)((const char*)Ab + (size_t)tt * (CW * 2) + lane * 16), (LAS unsigned*)(Aw + r * 1024), 16, 0, 0); }
        asm volatile("s_waitcnt vmcnt(0)" ::: "memory");
        __syncthreads();
        float av[62];
#pragma unroll
        for (int i = 0; i < 62; ++i) { const int s = s0 - 30 + i; const float ld = __uint_as_float((unsigned)(*(const LAS unsigned short*)(Aw + i * 1024 + c * 2)) << 16); av[i] = (s >= 0) ? ld : 0.f; }
        const float bd = b_dw[c];
#pragma unroll
        for (int i = 0; i < 32; ++i) { float y = bd;
#pragma unroll
            for (int j = 0; j < CONVK; ++j) y += wv[j] * av[i + j];
            Y[i * CW + c] = y; }
    }
    __syncthreads();
#pragma unroll
    for (int r = 0; r < 4; ++r) {
        const int i = wave * 4 + r;
        const f32x4 y0 = *(const LAS f32x4*)(Y + i * CW + 8 * lane), y1 = *(const LAS f32x4*)(Y + i * CW + 8 * lane + 4);
        float sm = (y0[0] + y0[1]) + (y0[2] + y0[3]) + (y1[0] + y1[1]) + (y1[2] + y1[3]);
        sm = wave_sum(sm);
        const float mu = sm * (1.0f / CW);
        const f32x4 d0 = y0 - mu, d1 = y1 - mu;
        float vq = (d0[0] * d0[0] + d0[1] * d0[1]) + (d0[2] * d0[2] + d0[3] * d0[3]) + (d1[0] * d1[0] + d1[1] * d1[1]) + (d1[2] * d1[2] + d1[3] * d1[3]);
        vq = wave_sum(vq);
        const float rstd = rsqrtf(vq * (1.0f / CW) + NORM_EPS);
        const f32x4 g0 = *(const f32x4*)(ln_g + 8 * lane), g1 = *(const f32x4*)(ln_g + 8 * lane + 4), b0 = *(const f32x4*)(ln_b + 8 * lane), b1 = *(const f32x4*)(ln_b + 8 * lane + 4);
        f32x4 z0 = d0 * rstd * g0 + b0, z1 = d1 * rstd * g1 + b1;
#pragma unroll
        for (int j = 0; j < 4; ++j) { z0[j] = silu_fast(z0[j]); z1[j] = silu_fast(z1[j]); }
        u32x4 w; w.x = pk_bf16(z0[0], z0[1]); w.y = pk_bf16(z0[2], z0[3]); w.z = pk_bf16(z1[0], z1[1]); w.w = pk_bf16(z1[2], z1[3]);
        *(u32x4*)(Z + (size_t)(t0 + i) * CW + 8 * lane) = w;
    }
    __syncthreads();
}

__device__ __forceinline__ void mix_phase(const bf16_t* O, const float* LSE, const bf16_t* CR, const float* g_a, const float* g_c, bf16_t* MIX) {
    const int lane = threadIdx.x & 63, wave = threadIdx.x >> 6, head = lane >> 3;
    for (int t = blockIdx.x * 8 + wave; t < NT; t += gridDim.x * 8) {
        float l0 = LSE[((size_t)0 * NT + t) * NHEAD + head], l1 = LSE[((size_t)1 * NT + t) * NHEAD + head], l2 = LSE[((size_t)2 * NT + t) * NHEAD + head];
        const float mm = fmaxf(l0, fmaxf(l1, l2));
        float w0 = __expf(l0 - mm), w1 = __expf(l1 - mm), w2 = __expf(l2 - mm); const float inv = 1.0f / (w0 + w1 + w2); w0 *= inv; w1 *= inv; w2 *= inv;
        const u32x4 a0 = *(const u32x4*)(O + ((size_t)0 * NT + t) * AW + 8 * lane), a1 = *(const u32x4*)(O + ((size_t)1 * NT + t) * AW + 8 * lane), a2 = *(const u32x4*)(O + ((size_t)2 * NT + t) * AW + 8 * lane);
        float v[8];
        v[0] = w0 * bf_lo(a0.x) + w1 * bf_lo(a1.x) + w2 * bf_lo(a2.x); v[1] = w0 * bf_hi(a0.x) + w1 * bf_hi(a1.x) + w2 * bf_hi(a2.x);
        v[2] = w0 * bf_lo(a0.y) + w1 * bf_lo(a1.y) + w2 * bf_lo(a2.y); v[3] = w0 * bf_hi(a0.y) + w1 * bf_hi(a1.y) + w2 * bf_hi(a2.y);
        v[4] = w0 * bf_lo(a0.z) + w1 * bf_lo(a1.z) + w2 * bf_lo(a2.z); v[5] = w0 * bf_hi(a0.z) + w1 * bf_hi(a1.z) + w2 * bf_hi(a2.z);
        v[6] = w0 * bf_lo(a0.w) + w1 * bf_lo(a1.w) + w2 * bf_lo(a2.w); v[7] = w0 * bf_hi(a0.w) + w1 * bf_hi(a1.w) + w2 * bf_hi(a2.w);
        float ss = 0.f;
#pragma unroll
        for (int j = 0; j < 8; ++j) ss += v[j] * v[j];
        ss = wave_sum(ss);
        float rstd = rsqrtf(ss * (1.0f / AW) + NORM_EPS);
        { const f32x4 g0 = *(const f32x4*)(g_a + 8 * lane), g1 = *(const f32x4*)(g_a + 8 * lane + 4);
          u32x4 w; w.x = pk_bf16(v[0] * rstd * g0[0], v[1] * rstd * g0[1]); w.y = pk_bf16(v[2] * rstd * g0[2], v[3] * rstd * g0[3]); w.z = pk_bf16(v[4] * rstd * g1[0], v[5] * rstd * g1[1]); w.w = pk_bf16(v[6] * rstd * g1[2], v[7] * rstd * g1[3]);
          *(u32x4*)(MIX + (size_t)t * DM + 8 * lane) = w; }
        if (CR == nullptr) continue;
        const u32x4 c0 = *(const u32x4*)(CR + (size_t)t * CW + 8 * lane);
        v[0] = bf_lo(c0.x); v[1] = bf_hi(c0.x); v[2] = bf_lo(c0.y); v[3] = bf_hi(c0.y); v[4] = bf_lo(c0.z); v[5] = bf_hi(c0.z); v[6] = bf_lo(c0.w); v[7] = bf_hi(c0.w);
        ss = 0.f;
#pragma unroll
        for (int j = 0; j < 8; ++j) ss += v[j] * v[j];
        ss = wave_sum(ss);
        rstd = rsqrtf(ss * (1.0f / CW) + NORM_EPS);
        { const f32x4 g0 = *(const f32x4*)(g_c + 8 * lane), g1 = *(const f32x4*)(g_c + 8 * lane + 4);
          u32x4 w; w.x = pk_bf16(v[0] * rstd * g0[0], v[1] * rstd * g0[1]); w.y = pk_bf16(v[2] * rstd * g0[2], v[3] * rstd * g0[3]); w.z = pk_bf16(v[4] * rstd * g1[0], v[5] * rstd * g1[1]); w.w = pk_bf16(v[6] * rstd * g1[2], v[7] * rstd * g1[3]);
          *(u32x4*)(MIX + (size_t)t * DM + AW + 8 * lane) = w; }
    }
}

__device__ __forceinline__ void ins8(float (&tv)[8], int (&ti)[8], float cv, int ci) {
#pragma unroll
    for (int p = 0; p < 8; ++p) { const bool gt = cv > tv[p]; const float ov = tv[p]; const int oi = ti[p]; tv[p] = gt ? cv : ov; ti[p] = gt ? ci : oi; cv = gt ? ov : cv; ci = gt ? oi : ci; }
}
__device__ __forceinline__ void route_phase(const Args& a, LAS unsigned char* lds, int gcnt_off) {
    const int tid = threadIdx.x, lane = tid & 63, j4 = tid & 3;
    unsigned char* ws = a.ws;
    const float* logits = (const float*)(ws + WS_ZB); const float* b_r = a.in[18];
    int* IDX = (int*)(ws + WS_IDX); float* RW = (float*)(ws + WS_RW); int* POS = (int*)(ws + WS_POS);
    unsigned* gcnt = (unsigned*)(ws + WS_CTL) + gcnt_off;
    LAS float* bias = (LAS float*)lds;
    LAS int* hist = (LAS int*)(lds + 1024);
    LAS int* base = (LAS int*)(lds + 2048);
    for (int i = tid; i < NEXP; i += 512) bias[i] = b_r[i];
    for (int blk = blockIdx.x; blk < NT / 128; blk += gridDim.x) {
        for (int i = tid; i < NEXP; i += 512) hist[i] = 0;
        __syncthreads();
        const int t = blk * 128 + (tid >> 2);
        float sb[64];
        { const f32x4* lp = (const f32x4*)(logits + (size_t)t * NEXP + 64 * j4);
#pragma unroll
          for (int c = 0; c < 16; ++c) { const f32x4 x = lp[c];
#pragma unroll
              for (int j = 0; j < 4; ++j) sb[4 * c + j] = 1.0f / (1.0f + expf(-x[j])) + bias[64 * j4 + 4 * c + j]; } }
        float gs2[2];
#pragma unroll
        for (int g = 0; g < 2; ++g) { float m1 = -1e30f, m2 = -1e30f;
#pragma unroll
            for (int i = 0; i < 32; ++i) { const float v = sb[32 * g + i]; const float n1 = fmaxf(m1, v); m2 = fmaxf(m2, fminf(m1, v)); m1 = n1; }
            gs2[g] = m1 + m2; }
        float gs[8];
#pragma unroll
        for (int g = 0; g < 8; ++g) gs[g] = __shfl((g & 1) ? gs2[1] : gs2[0], (lane & ~3) | (g >> 1));
        bool sel[2];
#pragma unroll
        for (int g2 = 0; g2 < 2; ++g2) { const int g = 2 * j4 + g2; const float me = (g2 == 0) ? gs2[0] : gs2[1]; int rank = 0;
#pragma unroll
            for (int o = 0; o < 8; ++o) rank += (gs[o] > me || (gs[o] == me && o < g)) ? 1 : 0;
            sel[g2] = rank < 4; }
        float tv[8]; int ti[8];
#pragma unroll
        for (int p = 0; p < 8; ++p) { tv[p] = -3e38f; ti[p] = 0; }
#pragma unroll
        for (int i = 0; i < 64; ++i) { const float v = sel[i >> 5] ? sb[i] : -1e30f; ins8(tv, ti, v, 64 * j4 + i); }
        float mv[8]; int mi[8];
#pragma unroll
        for (int p = 0; p < 8; ++p) { mv[p] = -3e38f; mi[p] = 0; }
#pragma unroll
        for (int src = 0; src < 4; ++src)
#pragma unroll
            for (int p = 0; p < 8; ++p) { const float v = __shfl(tv[p], (lane & ~3) | src); const int ix = __shfl(ti[p], (lane & ~3) | src); ins8(mv, mi, v, ix); }
        float wsum = 0.f; float wv[8];
#pragma unroll
        for (int p = 0; p < 8; ++p) { wv[p] = mv[p] - bias[mi[p]]; wsum += wv[p]; }
        const float wscale = 2.5f / wsum;
        int myk[2], mye[2], myr[2]; float myw[2];
#pragma unroll
        for (int p = 0; p < 8; ++p) { if ((p >> 1) == j4) { myk[p & 1] = p; mye[p & 1] = mi[p]; myw[p & 1] = wv[p] * wscale; } }
#pragma unroll
        for (int q = 0; q < 2; ++q) myr[q] = atomicAdd((int*)&hist[mye[q]], 1);
        __syncthreads();
        if (tid < NEXP) { const int h = hist[tid]; base[tid] = h ? (int)atomicAdd(&gcnt[tid * 32], (unsigned)h) : 0; }
        __syncthreads();
#pragma unroll
        for (int q = 0; q < 2; ++q) { const size_t o = (size_t)t * 8 + myk[q]; IDX[o] = mye[q]; RW[o] = myw[q]; POS[o] = base[mye[q]] + myr[q]; }
        __syncthreads();
    }
}

__device__ __forceinline__ void dispatch_phase(const Args& a, LAS unsigned char* lds) {
    const int tid = threadIdx.x;
    unsigned char* ws = a.ws;
    unsigned* ctl = (unsigned*)(ws + WS_CTL);
    const int* IDX = (const int*)(ws + WS_IDX); int* POS = (int*)(ws + WS_POS);
    int* AIDS = (int*)(ws + WS_AIDS); int* TEXP = (int*)(ws + WS_TEXP);
    LAS int* cnt = (LAS int*)lds; LAS int* pst = (LAS int*)(lds + 1024);
    for (int i = tid; i < NEXP; i += 512) cnt[i] = (int)ctl[CW_GCNT + i * 32];
    __syncthreads();
    if (tid == 0) { int s = 0; for (int e = 0; e < NEXP; ++e) { pst[e] = s; s += (cnt[e] + 255) & ~255; } pst[NEXP] = s; }
    __syncthreads();
    for (int id = blockIdx.x * 512 + tid; id < NT * 8; id += gridDim.x * 512) { const int e = IDX[id]; const int slot = pst[e] + POS[id]; AIDS[slot] = id; POS[id] = slot; }
    for (int e = blockIdx.x; e < NEXP; e += gridDim.x) {
        const int c = cnt[e], pc = (c + 255) & ~255, s0 = pst[e];
        for (int i = c + tid; i < pc; i += 512) AIDS[s0 + i] = -1;
        for (int i = tid; i < pc / 256; i += 512) TEXP[s0 / 256 + i] = e;
    }
    if (blockIdx.x == 0 && tid == 0) ctl[CW_NTILES] = (unsigned)(pst[NEXP] / 256);
}

__device__ __forceinline__ void final_phase(const Args& a, float* dst) {
    const int lane = threadIdx.x & 63, wave = __builtin_amdgcn_readfirstlane(threadIdx.x >> 6);
    const unsigned char* Y = a.ws + WS_YBUF; const bf16_t* X1 = (const bf16_t*)(a.ws + WS_X1B);
    const float* RW = (const float*)(a.ws + WS_RW);
    const float* gate = (const float*)(a.ws + WS_ADA) + 5120; const float* gf = a.in[25];
    for (int t = blockIdx.x * 8 + wave; t < NT; t += gridDim.x * 8) {
        const int b = t >> 13;
        float rw[9];
#pragma unroll
        for (int k = 0; k < 8; ++k) rw[k] = RW[(size_t)t * 8 + k] * 0.0625f;
        rw[8] = 0.0625f;
        u32x4 yw[9];
#pragma unroll
        for (int k = 0; k < 9; ++k) yw[k] = *(const u32x4*)(Y + ((size_t)t * 9 + k) * DM + 16 * lane);
        const u32x4 xw0 = *(const u32x4*)(X1 + (size_t)t * DM + 16 * lane), xw1 = *(const u32x4*)(X1 + (size_t)t * DM + 16 * lane + 8);
        float acc[16];
#pragma unroll
        for (int i = 0; i < 16; ++i) acc[i] = 0.f;
#pragma unroll
        for (int k = 0; k < 9; ++k)
#pragma unroll
            for (int q = 0; q < 4; ++q) { const int w = (int)yw[k][q];
                const f32x2 lo = __builtin_amdgcn_cvt_pk_f32_fp8(w, false), hi = __builtin_amdgcn_cvt_pk_f32_fp8(w, true);
                acc[4 * q + 0] += rw[k] * lo[0]; acc[4 * q + 1] += rw[k] * lo[1]; acc[4 * q + 2] += rw[k] * hi[0]; acc[4 * q + 3] += rw[k] * hi[1]; }
        float xv[16];
        xv[0] = bf_lo(xw0.x); xv[1] = bf_hi(xw0.x); xv[2] = bf_lo(xw0.y); xv[3] = bf_hi(xw0.y); xv[4] = bf_lo(xw0.z); xv[5] = bf_hi(xw0.z); xv[6] = bf_lo(xw0.w); xv[7] = bf_hi(xw0.w);
        xv[8] = bf_lo(xw1.x); xv[9] = bf_hi(xw1.x); xv[10] = bf_lo(xw1.y); xv[11] = bf_hi(xw1.y); xv[12] = bf_lo(xw1.z); xv[13] = bf_hi(xw1.z); xv[14] = bf_lo(xw1.w); xv[15] = bf_hi(xw1.w);
        float v[16]; float ss = 0.f;
#pragma unroll
        for (int q = 0; q < 4; ++q) { const f32x4 gv = *(const f32x4*)(gate + (size_t)b * 6144 + 16 * lane + 4 * q);
#pragma unroll
            for (int j = 0; j < 4; ++j) { const float y = xv[4 * q + j] + gv[j] * acc[4 * q + j]; v[4 * q + j] = y; ss += y * y; } }
        ss = wave_sum(ss);
        const float rstd = rsqrtf(ss * (1.0f / DM) + NORM_EPS);
#pragma unroll
        for (int q = 0; q < 4; ++q) { const f32x4 gv = *(const f32x4*)(gf + 16 * lane + 4 * q);
            f32x4 o; o[0] = v[4 * q + 0] * rstd * gv[0]; o[1] = v[4 * q + 1] * rstd * gv[1]; o[2] = v[4 * q + 2] * rstd * gv[2]; o[3] = v[4 * q + 3] * rstd * gv[3];
            *(f32x4*)(dst + (size_t)t * DM + 16 * lane + 4 * q) = o; }
    }
}

extern __shared__ __attribute__((aligned(16))) unsigned char dyn_lds[];

__global__ void __launch_bounds__(512, 2) __attribute__((amdgpu_waves_per_eu(2, 2))) hymba_fwd(Args a) {
    LAS unsigned char* lds = (LAS unsigned char*)dyn_lds;
    const int tid = threadIdx.x, G = gridDim.x, bx = blockIdx.x;
    unsigned char* ws = a.ws;
    unsigned* ctl = (unsigned*)(ws + WS_CTL);
    if (tid < 4) ((LAS unsigned*)(lds + LDS_BAR_OFF))[tid] = 0u;
    __syncthreads();
    XcdBarrier bar; bar.bar = ctl + CW_BAR; bar.x = 0; bar.st = (volatile LAS unsigned*)(lds + LDS_BAR_OFF);
    const bool one_launch = (a.ph_hi - a.ph_lo) > 1;
    if (one_launch) bar = xcd_barrier_post(ctl + CW_BAR, (volatile LAS unsigned*)(lds + LDS_BAR_OFF));
#define IN(k) (a.ph_lo <= (k) && (k) < a.ph_hi)
#define SEAM(k) do { if (IN(k) && IN((k) + 1)) xcd_barrier(bar); } while (0)
    const float* ada = (const float*)(ws + WS_ADA);
    const bool has_conv = (G == 256);
    const int Gc = has_conv ? 183 : G, cx = bx, nconv = G - Gc, kconv = bx - Gc; const bool is_conv = has_conv && bx >= Gc;
    constexpr int JSPLIT = 3900;
    const bool has_conv3 = has_conv;
    const int G3 = has_conv3 ? 154 : G, c3 = bx, nconv3 = G - G3, kconv3 = bx - G3; const bool is_conv3 = has_conv3 && bx >= G3;

#define RUN(k, ...) do { if (IN((k) % 100)) { __VA_ARGS__ } if (PROBE_PH == (k)) { if (IN((k) % 100)) { __VA_ARGS__ } if (IN((k) % 100)) { __VA_ARGS__ } } } while (0)
    RUN(0, p0_prologue(a, lds); );
    SEAM(0);
    RUN(1, normmod_phase(a.in[0], a.in[3], ada + 0, ada + 1024, (bf16_t*)(ws + WS_HB)); );
    SEAM(1);
    RUN(2,
        if (is_conv) convert_f8_jobs(a, lds, 0, JSPLIT, kconv, nconv);
        else {
        GemmDense g{(const char*)(ws + WS_HB), (const char*)(ws + WS_WIN), NT, NPROJ, DM * 2, DM * 2, Gc, cx};
        EpiInProj E{(bf16_t*)(ws + WS_QKV), (bf16_t*)(ws + WS_AB), (const float*)(ws + WS_ROPE)};
        gemm_phase(lds, g, E);
        }
    );
    SEAM(2);
#define P3X(AM_) do { if (IN(3) && !is_conv3) { const bf16_t* Q = (const bf16_t*)(ws + WS_QKV); const bf16_t* Kb = Q + (size_t)NT * AW; const bf16_t* Vb = Kb + (size_t)NT * AW; \
        for (int rep_ = 0; rep_ < 2; ++rep_) for (int u = c3; u < NB * NHEAD * 3 * 32; u += G3) attn_unit<AM_>(u, lds, Q, Kb, Vb, (bf16_t*)(ws + WS_OB), (float*)(ws + WS_LSE)); } } while (0)
    if (PROBE_PH == 1003) P3X(1);
    if (PROBE_PH == 2003) P3X(2);
    if (PROBE_PH == 3003) P3X(3);
    if (PROBE_PH == 4003) P3X(0);
    RUN(3,
        const bf16_t* Q = (const bf16_t*)(ws + WS_QKV); const bf16_t* Kb = Q + (size_t)NT * AW; const bf16_t* Vb = Kb + (size_t)NT * AW;
        if (!has_conv3 && has_conv) { if (is_conv) convert_f8_jobs(a, lds, JSPLIT, JOBS_F8, kconv, nconv); else for (int u = cx; u < NB * NHEAD * 3 * 32; u += Gc) attn_unit(u, lds, Q, Kb, Vb, (bf16_t*)(ws + WS_OB), (float*)(ws + WS_LSE)); }
        else if (is_conv3) convert_f8_jobs(a, lds, JSPLIT, JOBS_F8, kconv3, nconv3);
        else for (int u = c3; u < NB * NHEAD * 3 * 32; u += G3) attn_unit(u, lds, Q, Kb, Vb, (bf16_t*)(ws + WS_OB), (float*)(ws + WS_LSE));
    );
    RUN(103,
        for (int u = bx; u < NT / 32; u += G) conv_unit(u, lds, (const bf16_t*)(ws + WS_AB), a.in[7], a.in[8], a.in[9], a.in[10], (bf16_t*)(ws + WS_ZB));
    );
    SEAM(3);
    RUN(4,
        GemmDense g{(const char*)(ws + WS_ZB), (const char*)(ws + WS_WPW2), NT, CW, CW * 2, CW * 2, G, bx};
        EpiPw2Norm E{a.in[12], a.in[14], (bf16_t*)(ws + WS_QKV), (float*)(ws + WS_RWS) + 262144, ctl + CW_PANEL2, lds + LDS_XCH_OFF};
        gemm_phase(lds, g, E);
        mix_phase((const bf16_t*)(ws + WS_OB), (const float*)(ws + WS_LSE), nullptr, a.in[13], a.in[14], (bf16_t*)(ws + WS_QKV));
    );
    SEAM(5);
    RUN(6,
        GemmDense g{(const char*)(ws + WS_QKV), (const char*)(ws + WS_WOUT), NT, DM, DM * 2, DM * 2, G, bx};
        EpiOutNorm E{a.in[0], (bf16_t*)(ws + WS_X1B), ada, a.in[16], (bf16_t*)(ws + WS_HB), (unsigned char*)(ws + WS_H2F8), (float*)(ws + WS_RWS), ctl + CW_PANEL, lds + LDS_XCH_OFF};
        gemm_phase(lds, g, E);
    );
    SEAM(6);
    RUN(8,
        GemmDense g{(const char*)(ws + WS_HB), (const char*)(ws + WS_WR), NT, NEXP, DM * 2, DM * 2, G, bx};
        EpiF32 E{(float*)(ws + WS_ZB), NEXP};
        gemm_phase(lds, g, E);
    );
    SEAM(8);
    if (PROBE_PH == 9) { route_phase(a, lds, CW_GCNT + 8); route_phase(a, lds, CW_GCNT + 16); }
    RUN(109, route_phase(a, lds, CW_GCNT); );
    SEAM(9);
    RUN(10, dispatch_phase(a, lds); );
    SEAM(10);
#define P11X(MODE_) do { if (IN(11)) { const int ntiles = (int)__hip_atomic_load(ctl + CW_NTILES, __ATOMIC_RELAXED, __HIP_MEMORY_SCOPE_AGENT); \
        GemmGU g{(const char*)(ws + WS_H2F8), (const char*)(ws + WS_WGU), (const int*)(ws + WS_AIDS), (const int*)(ws + WS_TEXP), ntiles, DM, G, bx, lds + LDS_XCH_OFF + 20480}; EpiGU E{(unsigned char*)(ws + WS_HBUF)}; \
        gemm_phase<MODE_>(lds, g, E); gemm_phase<MODE_>(lds, g, E); } } while (0)
    if (PROBE_PH == 1011) P11X(1);
    if (PROBE_PH == 2011) P11X(2);
    if (PROBE_PH == 3011) P11X(3);
#define P12X(MODE_) do { if (IN(12)) { const int ntiles = (int)__hip_atomic_load(ctl + CW_NTILES, __ATOMIC_RELAXED, __HIP_MEMORY_SCOPE_AGENT); \
        GemmDown g{(const char*)(ws + WS_HBUF), (const char*)(ws + WS_WDT), (const int*)(ws + WS_TEXP), ntiles, FE, G, bx}; EpiDown E{(unsigned char*)(ws + WS_YBUF), lds + LDS_XCH_OFF, (const int*)(ws + WS_AIDS)}; \
        gemm_phase<MODE_>(lds, g, E); gemm_phase<MODE_>(lds, g, E); } } while (0)
    RUN(11,
        const int ntiles = (int)__hip_atomic_load(ctl + CW_NTILES, __ATOMIC_RELAXED, __HIP_MEMORY_SCOPE_AGENT);
        GemmGU g{(const char*)(ws + WS_H2F8), (const char*)(ws + WS_WGU), (const int*)(ws + WS_AIDS), (const int*)(ws + WS_TEXP), ntiles, DM, G, bx, lds + LDS_XCH_OFF + 20480};
        EpiGU E{(unsigned char*)(ws + WS_HBUF)};
        gemm_phase(lds, g, E);
    );
    SEAM(11);
    if (PROBE_PH == 1012) P12X(1);
    if (PROBE_PH == 2012) P12X(2);
    if (PROBE_PH == 3012) P12X(3);
    RUN(12,
        const int ntiles = (int)__hip_atomic_load(ctl + CW_NTILES, __ATOMIC_RELAXED, __HIP_MEMORY_SCOPE_AGENT);
        GemmDown g{(const char*)(ws + WS_HBUF), (const char*)(ws + WS_WDT), (const int*)(ws + WS_TEXP), ntiles, FE, G, bx};
        EpiDown E{(unsigned char*)(ws + WS_YBUF), lds + LDS_XCH_OFF, (const int*)(ws + WS_AIDS)};
        gemm_phase(lds, g, E);
    );
    SEAM(12);
    RUN(13, final_phase(a, a.out); );
#undef RUN
#undef IN
#undef SEAM
}

extern "C" void kernel_launch(void* const* d_in, const int* in_sizes, int n_in, void* d_out, int out_size, void* d_ws, size_t ws_size, hipStream_t stream) {
    static int grid = 0;
    if (grid == 0) {
        if (n_in != 26 || out_size != NT * DM || ws_size < WS_END) { fprintf(stderr, "kernel_launch: unexpected problem (n_in %d out %d ws %zu need %zu)\n", n_in, out_size, ws_size, (size_t)WS_END); grid = -1; return; }
        int dev = 0, cus = 0, per_cu = 0;
        if (hipGetDevice(&dev) != hipSuccess || hipDeviceGetAttribute(&cus, hipDeviceAttributeMultiprocessorCount, dev) != hipSuccess) { grid = -1; return; }
        if (hipFuncSetAttribute((const void*)hymba_fwd, hipFuncAttributeMaxDynamicSharedMemorySize, LDS_BYTES) != hipSuccess) { fprintf(stderr, "kernel_launch: hipFuncSetAttribute failed\n"); grid = -1; return; }
        if (hipOccupancyMaxActiveBlocksPerMultiprocessor(&per_cu, (const void*)hymba_fwd, 512, LDS_BYTES) != hipSuccess || per_cu < 1) fprintf(stderr, "kernel_launch: occupancy query says %d\n", per_cu);
        (void)hipGetLastError();
        grid = cus;
    }
    if (grid < 0) return;
    (void)hipMemsetAsync((char*)d_ws + WS_CTL, 0, CTL_BYTES, stream);
    Args a{};
    for (int i = 0; i < 26; ++i) a.in[i] = (const float*)d_in[i];
    a.out = (float*)d_out; a.ws = (unsigned char*)d_ws;
#if MK_N_LAUNCHES == 1
    a.ph_lo = 0; a.ph_hi = NPHASE;
    hipLaunchKernelGGL(hymba_fwd, dim3(grid), dim3(512), LDS_BYTES, stream, a);
#else
    for (int p = 0; p < NPHASE; ++p) { a.ph_lo = p; a.ph_hi = p + 1; hipLaunchKernelGGL(hymba_fwd, dim3(grid), dim3(512), LDS_BYTES, stream, a); }
#endif
}
```

```cpp
#include <hip/hip_runtime.h>
#include <stdint.h>
#include <stdio.h>

#ifndef MK_N_LAUNCHES
#define MK_N_LAUNCHES 1
#endif

#ifndef PROBE_PH
#define PROBE_PH (-1)
#endif

#define LAS __attribute__((address_space(3)))
typedef unsigned short bf16_t;
typedef short bf16x8 __attribute__((ext_vector_type(8)));
typedef float f32x4 __attribute__((ext_vector_type(4)));
typedef float f32x2 __attribute__((ext_vector_type(2)));
typedef unsigned u32x4 __attribute__((ext_vector_type(4)));
typedef unsigned u32x2 __attribute__((ext_vector_type(2)));

constexpr int NB = 4, SEQ = 8192, DM = 1024, NT = NB * SEQ;
constexpr int AW = 512, CW = 512, NHEAD = 8, HD = 64, NPROJ = 2560;
constexpr int NEXP = 256, TOPK = 8, FE = 256, CONVK = 31;
constexpr int NSLOT_MAX = NT * TOPK + NEXP * 256;
constexpr float NORM_EPS = 1e-6f;

constexpr size_t al256(size_t x) { return (x + 255) & ~(size_t)255; }
constexpr size_t WS_CTL   = 0;
constexpr size_t CTL_BYTES = 196608;
constexpr size_t WS_ADA   = WS_CTL + CTL_BYTES;
constexpr size_t WS_ROPE  = WS_ADA + al256((size_t)NB * 6144 * 4);
constexpr size_t WS_IDX   = WS_ROPE + (size_t)NT * 16 * 4;
constexpr size_t WS_RW    = WS_IDX + (size_t)NT * 8 * 4;
constexpr size_t WS_POS   = WS_RW + (size_t)NT * 8 * 4;
constexpr size_t WS_AIDS  = WS_POS + (size_t)NT * 8 * 4;
constexpr size_t WS_RWS   = WS_AIDS + (size_t)NSLOT_MAX * 4;
constexpr size_t WS_TEXP  = WS_RWS + (size_t)NSLOT_MAX * 4;
constexpr size_t WS_WDT   = WS_TEXP + 8192;
constexpr size_t WS_HBUF  = WS_WDT + (size_t)257 * 1024 * 256;
constexpr size_t WS_X1B   = WS_HBUF + (size_t)(NSLOT_MAX + NT) * 256;
constexpr size_t WS_OV    = WS_X1B + (size_t)NT * 1024 * 2;
constexpr size_t WS_WGU   = WS_OV;
constexpr size_t WS_WIN   = WS_WGU + (size_t)257 * 512 * 1024;
constexpr size_t WS_WOUT  = WS_WIN + (size_t)2560 * 1024 * 2;
constexpr size_t WS_WPW2  = WS_WOUT + (size_t)1024 * 1024 * 2;
constexpr size_t WS_WR    = WS_WPW2 + (size_t)512 * 512 * 2;
constexpr size_t WS_HB    = WS_WR + (size_t)256 * 1024 * 2;
constexpr size_t WS_QKV   = WS_HB + (size_t)NT * 1024 * 2;
constexpr size_t WS_AB    = WS_QKV + (size_t)3 * NT * 512 * 2;
constexpr size_t WS_OB    = WS_AB + (size_t)NT * 512 * 2;
constexpr size_t WS_LSE   = WS_OB + (size_t)3 * NT * 512 * 2;
constexpr size_t WS_ZB    = WS_LSE + (size_t)3 * NT * 8 * 4;
constexpr size_t WS_H2F8  = WS_ZB + (size_t)NT * 512 * 2;
constexpr size_t WS_OVEND = WS_H2F8 + (size_t)NT * 1024;
constexpr size_t WS_YBUF  = WS_OV;
constexpr size_t WS_YEND  = WS_YBUF + (size_t)NT * 9 * 1024;
constexpr size_t WS_END   = WS_OVEND > WS_YEND ? WS_OVEND : WS_YEND;
static_assert(WS_END <= (size_t)1 << 30, "workspace plan must fit 1 GiB");

constexpr int CW_BAR = 0;
constexpr int CW_GCNT = 8192;
constexpr int CW_NTILES = 4096 + 256;
constexpr int CW_PANEL2 = 32768;
constexpr int CW_PANEL = 16384;

constexpr int LDS_STAGE = 131072;
constexpr int LDS_BAR_OFF = LDS_STAGE;
constexpr int LDS_XCH_OFF = LDS_STAGE + 64;
constexpr int LDS_BYTES = 155648;

__device__ __forceinline__ unsigned pk_bf16(float lo, float hi) { unsigned r; asm volatile("v_cvt_pk_bf16_f32 %0, %1, %2" : "=v"(r) : "v"(lo), "v"(hi)); return r; }
__device__ __forceinline__ unsigned pk4_fp8(float a, float b, float c, float d) { int w = __builtin_amdgcn_cvt_pk_fp8_f32(a, b, 0, false); w = __builtin_amdgcn_cvt_pk_fp8_f32(c, d, w, true); return (unsigned)w; }
__device__ __forceinline__ float bf_lo(unsigned w) { return __uint_as_float(w << 16); }
__device__ __forceinline__ float bf_hi(unsigned w) { return __uint_as_float(w & 0xffff0000u); }
__device__ __forceinline__ float sigmoid_fast(float x) { return __builtin_amdgcn_rcpf(1.0f + __expf(-x)); }
__device__ __forceinline__ float silu_fast(float x) { return x * __builtin_amdgcn_rcpf(1.0f + __expf(-x)); }
__device__ __forceinline__ float wave_sum(float v) {
#pragma unroll
    for (int o = 32; o > 0; o >>= 1) v += __shfl_xor(v, o);
    return v;
}

#define XB_TMO      128
#define XB_XCNT(j)  (256  + 64 * (j))
#define XB_XSUB(j)  (1280 + 64 * (j))
#define XB_XGEN(j)  (2304 + 64 * (j))
#define XB_TOP      3328
#define XB_TOPGEN   3392
#define XCD_BAR_WORDS 3456
#define XB_SPIN_CAP (1u << 18)

__device__ __forceinline__ unsigned xb_ld(unsigned* p)              { return __hip_atomic_load(p, __ATOMIC_RELAXED, __HIP_MEMORY_SCOPE_AGENT); }
__device__ __forceinline__ unsigned xb_add(unsigned* p, unsigned v) { return __hip_atomic_fetch_add(p, v, __ATOMIC_RELAXED, __HIP_MEMORY_SCOPE_AGENT); }
__device__ __forceinline__ unsigned xb_xcc_id() { return (unsigned)__builtin_amdgcn_s_getreg((3 << 11) | 20) & 0xFu; }
#define XB_SPIN(cond, bar) do { unsigned _sp = 0; while (cond) { __builtin_amdgcn_s_sleep(1); \
    if ((++_sp & 255u) == 0u) { if (xb_ld(&(bar)[XB_TMO])) break; if (_sp > XB_SPIN_CAP) { atomicAdd(&(bar)[XB_TMO], 1u); break; } } } } while (0)

struct XcdBarrier { unsigned* bar; unsigned x; volatile LAS unsigned* st; };

__device__ __forceinline__ XcdBarrier xcd_barrier_post(unsigned* bar, volatile LAS unsigned* st) {
    XcdBarrier b; b.bar = bar; b.x = xb_xcc_id(); b.st = st;
    if (threadIdx.x == 0) (void)xb_add(&bar[XB_XCNT(b.x)], 1u);
    return b;
}
__device__ __forceinline__ void xcd_barrier_complete(unsigned* bar, unsigned x, unsigned& nloc, unsigned& nx) {
    const unsigned G = gridDim.x * gridDim.y * gridDim.z;
    unsigned sum, cnt, mine, sp = 0u;
    for (;;) {
        sum = 0u; cnt = 0u; mine = 0u;
#pragma unroll
        for (unsigned j = 0; j < 16; ++j) { const unsigned c = xb_ld(&bar[XB_XCNT(j)]); sum += c; cnt += (c > 0u) ? 1u : 0u; mine = (j == x) ? c : mine; }
        if (sum == G) break;
        __builtin_amdgcn_s_sleep(1);
        if ((++sp & 255u) == 0u) { if (xb_ld(&bar[XB_TMO])) break; if (sp > XB_SPIN_CAP) { atomicAdd(&bar[XB_TMO], 1u); break; } }
    }
    nloc = mine > 0u ? mine : 1u; nx = cnt > 0u ? cnt : 1u;
}
__device__ __forceinline__ void xcd_barrier(const XcdBarrier& b) {
    asm volatile("s_waitcnt vmcnt(0)" ::: "memory");
    __syncthreads();
    if (threadIdx.x == 0) {
        unsigned* bar = b.bar;
        __builtin_amdgcn_s_waitcnt(0);
        unsigned nloc = b.st[0], nx = b.st[1];
        if (nloc == 0u) { xcd_barrier_complete(bar, b.x, nloc, nx); b.st[0] = nloc; b.st[1] = nx; }
        const unsigned old = xb_add(&bar[XB_XSUB(b.x)], 1u);
        const unsigned gen = old / nloc;
        if (old + 1u == (gen + 1u) * nloc) {
            __builtin_amdgcn_fence(__ATOMIC_RELEASE, "agent");
            asm volatile("s_waitcnt vmcnt(0)" ::: "memory");
            const unsigned og = xb_add(&bar[XB_TOP], 1u);
            const unsigned tg = og / nx;
            if (og + 1u == (tg + 1u) * nx) xb_add(&bar[XB_TOPGEN], 1u);
            else XB_SPIN(xb_ld(&bar[XB_TOPGEN]) == tg, bar);
            __builtin_amdgcn_fence(__ATOMIC_ACQUIRE, "agent");
            xb_add(&bar[XB_XGEN(b.x)], 1u);
            asm volatile("s_waitcnt vmcnt(0)" ::: "memory");
        } else {
            XB_SPIN(xb_ld(&bar[XB_XGEN(b.x)]) == gen, bar);
            __builtin_amdgcn_fence(__ATOMIC_ACQUIRE, "agent");
            asm volatile("s_waitcnt vmcnt(0)" ::: "memory");
        }
    }
    __syncthreads();
}

constexpr int BM = 256, BK = 64, HALF = 128, HTB = HALF * BK * 2, NXCD = 8, WGM = 8;

__host__ __device__ __forceinline__ int lds_byte(int r, int c) { const int st = (r >> 4) * 2 + (c >> 5), rr = r & 15, cc = c & 31, ob = rr * 64 + cc * 2; return st * 1024 + (ob ^ (((ob >> 9) & 1) << 5)); }
__host__ __device__ __forceinline__ void stage_rc(int b, int& R, int& C) { const int st = b / 1024, sb = b % 1024, swz = sb ^ (((sb >> 9) & 1) << 5); R = (st >> 1) * 16 + swz / 64; C = (st & 1) * 32 + (swz % 64) / 2; }
__host__ __device__ __forceinline__ int perm32(int rho) { const int n = rho >> 4, i = rho & 15; return 8 * (i >> 2) + 4 * n + (i & 3); }

__host__ __device__ __forceinline__ int g8(int r16) { const int h = r16 >> 1; return (h < 2) ? h : (h < 6 ? h + 2 : h - 4); }
struct Unit { int pm, pn, e, kind; };

struct GemmDense {
    static constexpr bool F8 = false, GATHER = false;
    const char* A; const char* Bt; int M, N, KB, ldaB; int G, c;
    __device__ __forceinline__ bool next(int i, Unit& u) const {
        const int nM = M / BM, nN = N / BM, nwg = nM * nN;
        const long L = (long)i * G + c; if (L >= nwg) return false;
        int wgid = (int)L; { const int q = nwg / NXCD, r = nwg % NXCD, xcd = wgid % NXCD, off = wgid / NXCD; wgid = (xcd < r ? xcd * (q + 1) : r * (q + 1) + (xcd - r) * q) + off; }
        const int nig = WGM * nN, gid = wgid / nig, fm = gid * WGM, gsz = (nM - fm) < WGM ? (nM - fm) : WGM;
        u.pm = fm + ((wgid % nig) % gsz); u.pn = (wgid % nig) / gsz; u.e = i; u.kind = 0; return true;
    }
    __device__ __forceinline__ const char* a_base() const { return A; }
    __device__ __forceinline__ void a_off(const Unit& u, unsigned (&off)[2][2]) const {
        int tz = threadIdx.x; asm volatile("" : "+v"(tz));
#pragma unroll
        for (int i = 0; i < 2; ++i) { int R, C; stage_rc(tz * 16 + i * 8192, R, C);
#pragma unroll
            for (int h = 0; h < 2; ++h) off[h][i] = (unsigned)((size_t)(u.pm * BM + h * HALF + R) * ldaB + C * 2); }
    }
    __device__ __forceinline__ const char* b_ptr(const Unit& u) const { return Bt + (size_t)u.pn * BM * KB; }
    __device__ __forceinline__ const char* a_unit(const Unit& u) const { return A + (size_t)u.pm * BM * ldaB; }
    __device__ __forceinline__ int a_row_bytes() const { return ldaB; }
};

__device__ __forceinline__ int sload_i32(const int* p) { int v; asm volatile("s_load_dword %0, %1, 0x0\n\ts_waitcnt lgkmcnt(0)" : "=s"(v) : "s"(p) : "memory"); return v; }
struct GemmGU {
    static constexpr bool F8 = true, GATHER = true;
    const char* A; const char* W; const int* aids; const int* texp; int ntiles; int KB; int G, c; LAS unsigned char* idx;
    __device__ __forceinline__ bool next(int i, Unit& u) const {
        const int L = i * G + (((G & 7) == 0) ? (c & 7) * (G >> 3) + (c >> 3) : c); if (L >= (ntiles + NT / BM) * 2) return false;
        const int tile = L >> 1; u.pn = L & 1;
        if (tile < ntiles) { u.e = sload_i32(texp + tile); u.pm = tile * BM; u.kind = 0; } else { u.e = NEXP; u.pm = NSLOT_MAX + (tile - ntiles) * BM; u.kind = 1; }
        return true;
    }
    __device__ __forceinline__ const char* a_base() const { return A; }
    __device__ __forceinline__ void idx_issue(int upm, int ukind, int par, int wid) const {
        int tz = threadIdx.x; asm volatile("" : "+v"(tz)); const int lane = tz & 63;
        const int row = upm + (wid & 3) * 64 + lane;
        __builtin_amdgcn_global_load_lds((const unsigned*)(aids + (ukind == 0 ? row : lane)), (LAS unsigned*)(idx + par * 1024 + (wid & 3) * 256), 4, 0, 0);
    }
    __device__ __forceinline__ void a_off(const Unit& u, int par, unsigned (&off)[2][2]) const {
        int tz = threadIdx.x; asm volatile("" : "+v"(tz));
        const LAS int* ix = (const LAS int*)(idx + par * 1024);
        const bool sh = u.kind != 0;
#pragma unroll
        for (int i = 0; i < 2; ++i) { const int R = (tz >> 3) + 64 * i, C = 8 * ((tz & 7) ^ g8(R & 15));
#pragma unroll
            for (int h = 0; h < 2; ++h) { const int a = ix[h * HALF + R]; const int tok = sh ? u.pm + h * HALF + R - NSLOT_MAX : ((a < 0 ? 0 : a) >> 3);
                off[h][i] = (unsigned)((size_t)tok * DM + C * 2); } }
    }
    __device__ __forceinline__ const char* b_ptr(const Unit& u) const { return W + (size_t)(u.e * 2 + u.pn) * BM * DM; }
    __device__ __forceinline__ const char* a_unit(const Unit&) const { return A; }
    __device__ __forceinline__ int a_row_bytes() const { return DM; }
};
struct GemmDown {
    static constexpr bool F8 = true, GATHER = false;
    const char* A; const char* W; const int* texp; int ntiles; int KB; int G, c;
    __device__ __forceinline__ bool next(int i, Unit& u) const {
        const int L = i * G + (((G & 7) == 0) ? (c & 7) * (G >> 3) + (c >> 3) : c); if (L >= (ntiles + NT / BM) * 4) return false;
        const int tile = L >> 2; u.pn = L & 3;
        if (tile < ntiles) { u.e = sload_i32(texp + tile); u.pm = tile * BM; u.kind = 0; } else { u.e = NEXP; u.pm = NSLOT_MAX + (tile - ntiles) * BM; u.kind = 1; }
        return true;
    }
    __device__ __forceinline__ const char* a_base() const { return A; }
    __device__ __forceinline__ void a_off(const Unit& u, unsigned (&off)[2][2]) const {
        int tz = threadIdx.x; asm volatile("" : "+v"(tz));
#pragma unroll
        for (int i = 0; i < 2; ++i) { int R, C; stage_rc(tz * 16 + i * 8192, R, C);
#pragma unroll
            for (int h = 0; h < 2; ++h) off[h][i] = (unsigned)((size_t)(u.pm + h * HALF + R) * FE + C * 2); }
    }
    __device__ __forceinline__ const char* b_ptr(const Unit& u) const { return W + ((size_t)u.e * DM + (size_t)u.pn * BM) * FE; }
    __device__ __forceinline__ const char* a_unit(const Unit& u) const { return A + (size_t)u.pm * FE; }
    __device__ __forceinline__ int a_row_bytes() const { return FE; }
};

typedef int v8i_t __attribute__((ext_vector_type(8)));
template <bool F8> struct FragA { u32x4 v[4][2]; };
template <> struct FragA<true> { v8i_t v[4]; };
template <bool F8> struct FragB { u32x4 v[2][2]; };
template <> struct FragB<true> { v8i_t v[2]; };
constexpr float F8_WSCALE = 64.0f, F8_WINV = 1.0f / 64.0f;
template <class E, class = void> struct HasPf { static constexpr bool v = false; };
template <class E> struct HasPf<E, decltype((void)E::PF)> { static constexpr bool v = true; };
template <class E, class = void> struct HasTop { static constexpr bool v = false; };
template <class E> struct HasTop<E, decltype((void)E::TOP)> { static constexpr bool v = true; };
template <int MODE = 0, class P, class Epi>
__device__ __forceinline__ void gemm_phase(LAS unsigned char* lds, const P& p, const Epi& E) {
    const int tid = threadIdx.x, wid = __builtin_amdgcn_readfirstlane(tid >> 6), lane = tid & 63, wr = wid >> 2, wc = wid & 3, fr = lane & 15, fq = lane >> 4;
    constexpr bool DS = HasPf<Epi>::v && MODE == 0;
    const int KB = p.KB, nt = KB / 128;
    unsigned voffB;
    { int R, C; if constexpr (P::F8) { R = tid >> 3; C = 8 * ((tid & 7) ^ g8(R & 15)); } else stage_rc(tid * 16, R, C);
      const int Rb = Epi::PERM ? ((R & ~31) + perm32(R & 31)) : R; voffB = (unsigned)(Rb * KB + C * 2); }
    const size_t p1B = (size_t)64 * KB;
    const size_t kstep = 128;
    const size_t hstep = (size_t)HALF * KB;
    const unsigned ldsw = (unsigned)wid * 1024u;
    const int foff8 = fr * 128 + 16 * ((2 * fq) ^ g8(fr));
    const int aoff = P::F8 ? wr * 8192 + foff8 : lds_byte(wr * 64 + fr, fq * 8), boff = P::F8 ? wc * 4096 + foff8 : lds_byte(wc * 32 + fr, fq * 8);
    const int aoff2 = aoff ^ 16, boff2 = boff ^ 16;
#define G_SA(b, h) (((b) * 2 + (h)) * HTB)
#define G_SB(b, h) ((4 + (b) * 2 + (h)) * HTB)
#define G_STAGE2(bufoff, gbase, voff, kb) do { if constexpr (MODE != 3) _Pragma("unroll") for (int _i = 0; _i < 2; ++_i) \
        __builtin_amdgcn_global_load_lds((const unsigned*)((const char*)(gbase) + (unsigned)((voff)[_i] + (unsigned)(kb))), (LAS unsigned*)(lds + (bufoff) + ldsw + _i * 8192), 16, 0, 0); } while (0)
#define G_STAGE1(bufoff, gbase, voff, p1) do { if constexpr (MODE != 3) _Pragma("unroll") for (int _i = 0; _i < 2; ++_i) \
        __builtin_amdgcn_global_load_lds((const unsigned*)((const char*)(gbase) + _i * (p1) + (voff)), (LAS unsigned*)(lds + (bufoff) + ldsw + _i * 8192), 16, 0, 0); } while (0)
#define G_STAGE(bufoff, gbase, voff) G_STAGE1(bufoff, gbase, voff, p1B)
#define G_LDA(dst, b, h) do { _Pragma("unroll") for (int m = 0; m < 4; ++m) { if constexpr (P::F8) { const u32x4 lo_ = *(const LAS u32x4*)(lds + G_SA(b, h) + aoff + m * 2048), hi_ = *(const LAS u32x4*)(lds + G_SA(b, h) + aoff2 + m * 2048); dst.v[m] = (v8i_t){(int)lo_.x, (int)lo_.y, (int)lo_.z, (int)lo_.w, (int)hi_.x, (int)hi_.y, (int)hi_.z, (int)hi_.w}; } \
        else { _Pragma("unroll") for (int k = 0; k < 2; ++k) dst.v[m][k] = *(const LAS u32x4*)(lds + G_SA(b, h) + aoff + m * 2048 + k * 1024); } } } while (0)
#define G_LDB(dst, b, h) do { _Pragma("unroll") for (int n = 0; n < 2; ++n) { if constexpr (P::F8) { const u32x4 lo_ = *(const LAS u32x4*)(lds + G_SB(b, h) + boff + n * 2048), hi_ = *(const LAS u32x4*)(lds + G_SB(b, h) + boff2 + n * 2048); dst.v[n] = (v8i_t){(int)lo_.x, (int)lo_.y, (int)lo_.z, (int)lo_.w, (int)hi_.x, (int)hi_.y, (int)hi_.z, (int)hi_.w}; } \
        else { _Pragma("unroll") for (int k = 0; k < 2; ++k) dst.v[n][k] = *(const LAS u32x4*)(lds + G_SB(b, h) + boff + n * 2048 + k * 1024); } } } while (0)
#define G_MMA(ai, bj, At, Bt) do { if constexpr (MODE == 2) { _Pragma("unroll") for (int m = 0; m < 4; ++m) asm volatile("" :: "v"(At.v[m])); _Pragma("unroll") for (int n = 0; n < 2; ++n) asm volatile("" :: "v"(Bt.v[n])); } else { __builtin_amdgcn_s_setprio(1); _Pragma("unroll") for (int m = 0; m < 4; ++m) _Pragma("unroll") for (int n = 0; n < 2; ++n) { \
        if constexpr (P::F8) acc[ai][bj][m][n] = __builtin_amdgcn_mfma_scale_f32_16x16x128_f8f6f4(Bt.v[n], At.v[m], acc[ai][bj][m][n], 0, 0, 0, 0, 0, 0); \
        else { _Pragma("unroll") for (int k = 0; k < 2; ++k) acc[ai][bj][m][n] = __builtin_amdgcn_mfma_f32_16x16x32_bf16(__builtin_bit_cast(bf16x8, Bt.v[n][k]), __builtin_bit_cast(bf16x8, At.v[m][k]), acc[ai][bj][m][n], 0, 0, 0); } } \
        if constexpr (P::F8) { _Pragma("unroll") for (int m = 0; m < 4; ++m) _Pragma("unroll") for (int n = 0; n < 2; ++n) asm volatile("" : "+v"(acc[ai][bj][m][n])); } \
        __builtin_amdgcn_s_setprio(0); } } while (0)
#define G_WAIT_V(n) asm volatile("s_waitcnt vmcnt(" #n ")" ::: "memory")
#define G_WAIT_L(n) asm volatile("s_waitcnt lgkmcnt(" #n ")" ::: "memory")
#define G_BAR __builtin_amdgcn_s_barrier()
#define G_SCHED __builtin_amdgcn_sched_barrier(0)
    Unit cur, nxt; int ui = 0;
    if (!p.next(0, cur)) return;
    f32x4 acc[2][2][4][2];
#pragma unroll
    for (int a = 0; a < 2; ++a)
#pragma unroll
        for (int b = 0; b < 2; ++b)
#pragma unroll
            for (int m = 0; m < 4; ++m)
#pragma unroll
                for (int n = 0; n < 2; ++n) acc[a][b][m][n] = (f32x4){0.f, 0.f, 0.f, 0.f};
    FragA<P::F8> At; FragB<P::F8> B0, B1;
    unsigned ao_cur[2][2], ao_nxt[2][2], voffA = 0;
    const char* pA_cur = p.a_unit(cur); const char* pA_nxt = pA_cur;
    const size_t hstepA = (size_t)HALF * p.a_row_bytes();
    if constexpr (P::GATHER) { p.idx_issue(cur.pm, cur.kind, 0, wid); G_WAIT_V(0); G_BAR; p.a_off(cur, 0, ao_cur); }
    else { int R, C; if constexpr (P::F8) { R = tid >> 3; C = 8 * ((tid & 7) ^ g8(R & 15)); } else stage_rc(tid * 16, R, C); voffA = (unsigned)(R * p.a_row_bytes() + C * 2); }
    const size_t p1A = (size_t)64 * p.a_row_bytes();
#define G_STAGE_A(bufoff, U, h, kb) do { if constexpr (P::GATHER) G_STAGE2(bufoff, pA_cur, ao_##U[h], kb); else G_STAGE1(bufoff, pA_##U + (h) * hstepA + (kb), voffA, p1A); } while (0)
    const char* cB = p.b_ptr(cur);
    if constexpr (HasTop<Epi>::v && MODE == 0) { if (wr == 1) E.top_issue(cur); }
    G_STAGE(G_SB(0, 0), cB, voffB); G_STAGE_A(G_SA(0, 0), cur, 0, 0); G_STAGE(G_SB(0, 1), cB + hstep, voffB); G_STAGE_A(G_SA(0, 1), cur, 1, 0);
    if (wr == 1) G_BAR;
    G_WAIT_V(4); G_BAR;
    G_STAGE(G_SB(1, 0), cB + kstep, voffB); G_STAGE_A(G_SA(1, 0), cur, 0, kstep); G_STAGE(G_SB(1, 1), cB + hstep + kstep, voffB);
    if constexpr (DS) { G_STAGE_A(G_SA(1, 1), cur, 1, kstep); E.pf_issue(cur.pm, cur.kind, 0, wr, wc); G_WAIT_V(0); G_BAR; }
    else { G_WAIT_V(6); G_BAR; }
#define G_TRIP(K1, U2, K2, B2) do { \
            G_LDB(B0, 0, 0); G_SCHED; G_LDA(At, 0, 0); G_STAGE_A(G_SA(1, 1), cur, 1, (K1)); \
            G_WAIT_L(8); G_BAR; G_WAIT_L(0); G_MMA(0, 0, At, B0); G_BAR; G_SCHED; \
            G_LDB(B1, 0, 1); G_STAGE(G_SB(0, 0), (B2), voffB); \
            G_BAR; G_WAIT_L(0); G_MMA(0, 1, At, B1); G_BAR; \
            G_LDA(At, 0, 1); G_STAGE_A(G_SA(0, 0), U2, 0, (K2)); \
            G_BAR; G_WAIT_L(0); G_MMA(1, 0, At, B0); G_BAR; G_SCHED; \
            G_STAGE(G_SB(0, 1), (B2) + hstep, voffB); \
            G_WAIT_V(6); G_BAR; G_MMA(1, 1, At, B1); G_BAR; \
            G_LDB(B0, 1, 0); G_SCHED; G_LDA(At, 1, 0); G_STAGE_A(G_SA(0, 1), U2, 1, (K2)); \
            G_WAIT_L(8); G_BAR; G_WAIT_L(0); G_MMA(0, 0, At, B0); G_BAR; G_SCHED; \
            G_LDB(B1, 1, 1); G_STAGE(G_SB(1, 0), (B2) + kstep, voffB); \
            G_BAR; G_WAIT_L(0); G_MMA(0, 1, At, B1); G_BAR; \
            G_LDA(At, 1, 1); G_STAGE_A(G_SA(1, 0), U2, 0, (K2) + kstep); \
            G_BAR; G_WAIT_L(0); G_MMA(1, 0, At, B0); G_BAR; G_SCHED; \
            G_STAGE(G_SB(1, 1), (B2) + kstep + hstep, voffB); \
            G_WAIT_V(6); G_BAR; G_MMA(1, 1, At, B1); G_BAR; } while (0)
#define G_TRIP_D(B2) do { \
            G_LDB(B0, 0, 0); G_SCHED; G_LDA(At, 0, 0); \
            G_WAIT_L(8); G_BAR; G_WAIT_L(0); G_MMA(0, 0, At, B0); G_BAR; G_SCHED; \
            G_LDB(B1, 0, 1); G_STAGE(G_SB(0, 0), (B2), voffB); \
            G_BAR; G_WAIT_L(0); G_MMA(0, 1, At, B1); G_BAR; \
            G_LDA(At, 0, 1); G_STAGE_A(G_SA(0, 0), nxt, 0, (size_t)0); \
            G_BAR; G_WAIT_L(0); G_MMA(1, 0, At, B0); G_BAR; G_SCHED; \
            G_STAGE(G_SB(0, 1), (B2) + hstep, voffB); \
            G_WAIT_V(15); G_BAR; G_MMA(1, 1, At, B1); G_BAR; \
            G_LDB(B0, 1, 0); G_SCHED; G_LDA(At, 1, 0); G_STAGE_A(G_SA(0, 1), nxt, 1, (size_t)0); \
            G_WAIT_L(8); G_BAR; G_WAIT_L(0); G_MMA(0, 0, At, B0); G_BAR; G_SCHED; \
            G_LDB(B1, 1, 1); G_STAGE(G_SB(1, 0), (B2) + kstep, voffB); \
            G_BAR; G_WAIT_L(0); G_MMA(0, 1, At, B1); G_BAR; \
            G_LDA(At, 1, 1); G_STAGE_A(G_SA(1, 0), nxt, 0, kstep); \
            G_BAR; G_WAIT_L(0); G_MMA(1, 0, At, B0); G_BAR; G_SCHED; \
            G_STAGE(G_SB(1, 1), (B2) + kstep + hstep, voffB); \
            G_BAR; G_MMA(1, 1, At, B1); G_BAR; \
            G_STAGE_A(G_SA(1, 1), nxt, 1, kstep); } while (0)
    for (;;) {
        const bool has_next = p.next(ui + 1, nxt);
        if constexpr (P::GATHER) p.idx_issue(has_next ? nxt.pm : cur.pm, has_next ? nxt.kind : cur.kind, (ui + 1) & 1, wid);
        for (int t = 0; t < nt - 2; t += 2) {
            const size_t k1 = (size_t)(t + 1) * kstep;
            G_TRIP(k1, cur, k1 + kstep, cB + k1 + kstep);
        }
        const char* nB = cB;
        if (has_next) { if constexpr (P::GATHER) p.a_off(nxt, (ui + 1) & 1, ao_nxt); else pA_nxt = p.a_unit(nxt); nB = p.b_ptr(nxt); }
        else { if constexpr (P::GATHER) {
#pragma unroll
            for (int h = 0; h < 2; ++h)
#pragma unroll
                for (int i = 0; i < 2; ++i) ao_nxt[h][i] = ao_cur[h][i]; } else pA_nxt = pA_cur; }
        if constexpr (DS) { E.pf_issue(has_next ? nxt.pm : cur.pm, has_next ? nxt.kind : cur.kind, (ui + 1) & 1, wr, wc); G_TRIP_D(nB); }
        else G_TRIP((size_t)(nt - 1) * kstep, nxt, (size_t)0, nB);
        if (wr == 0) G_BAR;
        { int tz = threadIdx.x; asm volatile("" : "+v"(tz)); const int l2 = tz & 63; if constexpr (MODE == 0) { if constexpr (DS) E(acc, cur, wr, wc, l2 & 15, l2 >> 4, ui & 1); else E(acc, cur, wr, wc, l2 & 15, l2 >> 4); } else { _Pragma("unroll") for (int a_ = 0; a_ < 2; ++a_) _Pragma("unroll") for (int b_ = 0; b_ < 2; ++b_) _Pragma("unroll") for (int m_ = 0; m_ < 4; ++m_) _Pragma("unroll") for (int n_ = 0; n_ < 2; ++n_) asm volatile("" :: "v"(acc[a_][b_][m_][n_])); } }
        if (!has_next) break;
        if constexpr (DS) { G_WAIT_V(16); G_BAR; }
        if (wr == 1) G_BAR;
        if constexpr (HasTop<Epi>::v && MODE == 0) { if (wr == 1) E.top_issue(nxt); }
#pragma unroll
        for (int a = 0; a < 2; ++a)
#pragma unroll
            for (int b = 0; b < 2; ++b)
#pragma unroll
                for (int m = 0; m < 4; ++m)
#pragma unroll
                    for (int n = 0; n < 2; ++n) acc[a][b][m][n] = (f32x4){0.f, 0.f, 0.f, 0.f};
        if constexpr (P::GATHER) {
#pragma unroll
            for (int h = 0; h < 2; ++h)
#pragma unroll
                for (int i = 0; i < 2; ++i) ao_cur[h][i] = ao_nxt[h][i]; } else pA_cur = pA_nxt;
        cur = nxt; cB = nB; ++ui;
    }
    G_WAIT_V(0);
    G_BAR;
#undef G_TRIP
#undef G_TRIP_D
#undef G_STAGE_A
#undef G_SA
#undef G_SB
#undef G_STAGE
#undef G_STAGE1
#undef G_STAGE2
#undef G_LDA
#undef G_LDB
#undef G_MMA
}

typedef f32x4 Acc[2][2][4][2];

struct EpiF32 {
    static constexpr bool PERM = false;
    float* C; int ldc;
    __device__ __forceinline__ void operator()(const Acc& acc, const Unit& u, int wr, int wc, int fr, int fq) const {
        const int row0 = u.pm * BM + wr * 64 + fr, col0 = u.pn * BM + wc * 32 + 4 * fq;
#pragma unroll
        for (int ai = 0; ai < 2; ++ai)
#pragma unroll
            for (int m = 0; m < 4; ++m) { float* rowp = C + (size_t)(row0 + ai * HALF + m * 16) * ldc + col0;
#pragma unroll
                for (int bj = 0; bj < 2; ++bj)
#pragma unroll
                    for (int n = 0; n < 2; ++n) *(f32x4*)(rowp + bj * HALF + n * 16) = acc[ai][bj][m][n]; }
    }
};
struct EpiBf16Bias {
    static constexpr bool PERM = true;
    bf16_t* O; int ldc; const float* bias;
    __device__ __forceinline__ void operator()(const Acc& acc, const Unit& u, int wr, int wc, int fr, int fq) const {
        const int row0 = u.pm * BM + wr * 64 + fr, col0 = u.pn * BM + wc * 32 + 8 * fq;
        f32x4 bv[2][2];
#pragma unroll
        for (int bj = 0; bj < 2; ++bj)
#pragma unroll
            for (int n = 0; n < 2; ++n) bv[bj][n] = *(const f32x4*)(bias + col0 + bj * HALF + 4 * n);
#pragma unroll
        for (int ai = 0; ai < 2; ++ai)
#pragma unroll
            for (int m = 0; m < 4; ++m) { bf16_t* rowp = O + (size_t)(row0 + ai * HALF + m * 16) * ldc + col0;
#pragma unroll
                for (int bj = 0; bj < 2; ++bj) { const f32x4 v0 = acc[ai][bj][m][0] + bv[bj][0], v1 = acc[ai][bj][m][1] + bv[bj][1];
                    u32x4 w; w.x = pk_bf16(v0[0], v0[1]); w.y = pk_bf16(v0[2], v0[3]); w.z = pk_bf16(v1[0], v1[1]); w.w = pk_bf16(v1[2], v1[3]);
                    *(u32x4*)(rowp + bj * HALF) = w; } }
    }
};
struct EpiInProj {
    static constexpr bool PERM = true;
    static constexpr bool TOP = true;
    bf16_t* qkv; bf16_t* abuf; const float* rope; LAS unsigned char* lr;
    __device__ __forceinline__ void top_issue(const Unit& u) const {
        int tz = threadIdx.x; asm volatile("" : "+v"(tz)); const int lane = tz & 63; const int w = __builtin_amdgcn_readfirstlane((tz >> 6) & 3);
        const char* src = (const char*)(rope + (size_t)u.pm * BM * 16);
#pragma unroll
        for (int i = 0; i < 4; ++i) __builtin_amdgcn_global_load_lds((const unsigned*)(src + (i * 256 + w * 64 + lane) * 16), (LAS unsigned*)(lr + (i * 256 + w * 64) * 16), 16, 0, 0);
    }
    __device__ __forceinline__ void operator()(const Acc& acc, const Unit& u, int wr, int wc, int fr, int fq) const {
        const int row0 = u.pm * BM + wr * 64 + fr;
        if (u.pn < 6) {
            const int which = u.pn >> 1;
            const bool rot = (which < 2) && ((wc & 1) == 0);
            const float qs = (which == 0) ? 0.125f : 1.0f;
            bf16_t* dst = qkv + (size_t)which * NT * AW;
            const float sg = (fq == 0) ? -1.0f : 1.0f;
            f32x4 ra[4], rb[4];
#define IP_LOAD(dst_, g) do { const LAS unsigned char* rp_ = lr + (wr * 64 + fr + ((g) >> 2) * HALF + ((g) & 3) * 16) * 64; _Pragma("unroll") for (int j_ = 0; j_ < 4; ++j_) dst_[j_] = *(const LAS f32x4*)(rp_ + 16 * j_); } while (0)
#define IP_GROUP(ROT, cs_, g) do { const int ai = (g) >> 2, m = (g) & 3; const int row = row0 + ai * HALF + m * 16, b = row >> 13, s = row & (SEQ - 1); \
                _Pragma("unroll") for (int bj = 0; bj < 2; ++bj) { float v[8]; \
                    _Pragma("unroll") for (int j = 0; j < 4; ++j) { v[j] = acc[ai][bj][m][0][j]; v[4 + j] = acc[ai][bj][m][1][j]; } \
                    if (ROT) { _Pragma("unroll") for (int j = 0; j < 8; ++j) { const float pv = __shfl_xor(v[j], 16); const float r = v[j] * cs_[j >> 2][j & 3] + sg * pv * cs_[2 + (j >> 2)][j & 3]; v[j] = (fq < 2) ? r : v[j]; } } \
                    const int head = (u.pn & 1) * 4 + 2 * bj + (wc >> 1), colh = 32 * (wc & 1) + 8 * fq; \
                    u32x4 w; w.x = pk_bf16(v[0] * qs, v[1] * qs); w.y = pk_bf16(v[2] * qs, v[3] * qs); w.z = pk_bf16(v[4] * qs, v[5] * qs); w.w = pk_bf16(v[6] * qs, v[7] * qs); \
                    *(u32x4*)(dst + ((size_t)(b * NHEAD + head) * SEQ + s) * HD + colh) = w; } } while (0)
            if (rot) {
                IP_LOAD(ra, 0);
#pragma unroll
                for (int g = 0; g < 8; g += 2) {
                    IP_LOAD(rb, g + 1);
                    asm volatile("" ::: "memory");
                    IP_GROUP(true, ra, g);
                    if (g + 2 < 8) IP_LOAD(ra, g + 2);
                    asm volatile("" ::: "memory");
                    IP_GROUP(true, rb, g + 1);
                }
            } else {
#pragma unroll
                for (int g = 0; g < 8; ++g) IP_GROUP(false, ra, g);
            }
#undef IP_LOAD
#undef IP_GROUP
        } else {
            const int ch0 = (u.pn - 6) * 128 + wc * 32 + 8 * fq;
#pragma unroll
            for (int ai = 0; ai < 2; ++ai)
#pragma unroll
                for (int m = 0; m < 4; ++m) {
                    const int row = row0 + ai * HALF + m * 16;
                    float v[8];
#pragma unroll
                    for (int j = 0; j < 4; ++j) { v[j] = acc[ai][0][m][0][j] * sigmoid_fast(acc[ai][1][m][0][j]); v[4 + j] = acc[ai][0][m][1][j] * sigmoid_fast(acc[ai][1][m][1][j]); }
                    u32x4 w; w.x = pk_bf16(v[0], v[1]); w.y = pk_bf16(v[2], v[3]); w.z = pk_bf16(v[4], v[5]); w.w = pk_bf16(v[6], v[7]);
                    *(u32x4*)(abuf + (size_t)row * CW + ch0) = w;
                }
        }
    }
};
struct EpiOut {
    static constexpr bool PERM = true;
    const float* __restrict__ x; bf16_t* __restrict__ x1; const float* __restrict__ gate;
    __device__ __forceinline__ void operator()(const Acc& acc, const Unit& u, int wr, int wc, int fr, int fq) const {
        const int row0 = u.pm * BM + wr * 64 + fr, col0 = u.pn * BM + wc * 32 + 8 * fq;
        const int b = (u.pm * BM) >> 13;
        f32x4 gv[2][2];
#pragma unroll
        for (int bj = 0; bj < 2; ++bj)
#pragma unroll
            for (int n = 0; n < 2; ++n) gv[bj][n] = *(const f32x4*)(gate + (size_t)b * 6144 + col0 + bj * HALF + n * 4);
        f32x4 xa[2][2], xb[2][2];
#define EO_LOAD(dst, g) do { const size_t off_ = (size_t)(row0 + ((g) >> 2) * HALF + ((g) & 3) * 16) * DM + col0; _Pragma("unroll") for (int bj = 0; bj < 2; ++bj) _Pragma("unroll") for (int n = 0; n < 2; ++n) dst[bj][n] = *(const f32x4*)(x + off_ + bj * HALF + n * 4); } while (0)
#define EO_STORE(srcv, g) do { const size_t off_ = (size_t)(row0 + ((g) >> 2) * HALF + ((g) & 3) * 16) * DM + col0; _Pragma("unroll") for (int bj = 0; bj < 2; ++bj) { \
            const f32x4 v0 = srcv[bj][0] + gv[bj][0] * acc[(g) >> 2][bj][(g) & 3][0], v1 = srcv[bj][1] + gv[bj][1] * acc[(g) >> 2][bj][(g) & 3][1]; \
            u32x4 w; w.x = pk_bf16(v0[0], v0[1]); w.y = pk_bf16(v0[2], v0[3]); w.z = pk_bf16(v1[0], v1[1]); w.w = pk_bf16(v1[2], v1[3]); *(u32x4*)(x1 + off_ + bj * HALF) = w; } } while (0)
        EO_LOAD(xa, 0);
#pragma unroll
        for (int g = 0; g < 8; g += 2) {
            EO_LOAD(xb, g + 1);
            asm volatile("" ::: "memory");
            EO_STORE(xa, g);
            if (g + 2 < 8) EO_LOAD(xa, g + 2);
            asm volatile("" ::: "memory");
            EO_STORE(xb, g + 1);
        }
#undef EO_LOAD
#undef EO_STORE
    }
};
typedef float f32x2_t __attribute__((ext_vector_type(2)));
__device__ __forceinline__ f32x4 load_sc1_x4(const float* p) { f32x4 v; asm volatile("global_load_dwordx4 %0, %1, off sc1\n\ts_waitcnt vmcnt(0)" : "=&v"(v) : "v"(p) : "memory"); return v; }
__device__ __forceinline__ f32x2_t load_sc1_x2(const float* p) { f32x2_t v; asm volatile("global_load_dwordx2 %0, %1, off sc1\n\ts_waitcnt vmcnt(0)" : "=&v"(v) : "v"(p) : "memory"); return v; }
struct EpiOutNorm {
    static constexpr bool PERM = true;
    const float* __restrict__ x; bf16_t* __restrict__ x1; const float* __restrict__ ada; const float* __restrict__ g2;
    bf16_t* __restrict__ h2; unsigned char* __restrict__ h28; float* xb; unsigned* cnt; LAS unsigned char* lx;
    __device__ __forceinline__ void operator()(Acc& acc, const Unit& u, int wr, int wc, int fr, int fq) const {
        const int row0 = u.pm * BM + wr * 64 + fr, col0 = u.pn * BM + wc * 32 + 8 * fq;
        const float* adab = ada + (size_t)((u.pm * BM) >> 13) * 6144;
        float ps[8];
        {
            f32x4 gv[2][2];
#pragma unroll
            for (int bj = 0; bj < 2; ++bj)
#pragma unroll
                for (int n = 0; n < 2; ++n) gv[bj][n] = *(const f32x4*)(adab + 2048 + col0 + bj * HALF + n * 4);
            f32x4 xa[2][2], xb2[2][2];
#define EN_LOAD(dst, g) do { const unsigned off_ = (unsigned)((row0 + ((g) >> 2) * HALF + ((g) & 3) * 16) * DM + col0); _Pragma("unroll") for (int bj = 0; bj < 2; ++bj) _Pragma("unroll") for (int n = 0; n < 2; ++n) dst[bj][n] = *(const f32x4*)((const char*)x + (off_ + bj * HALF + n * 4) * 4u); } while (0)
#define EN_STORE(srcv, g) do { const unsigned off_ = (unsigned)((row0 + ((g) >> 2) * HALF + ((g) & 3) * 16) * DM + col0); float s_ = 0.f; _Pragma("unroll") for (int bj = 0; bj < 2; ++bj) { \
                const f32x4 v0 = srcv[bj][0] + gv[bj][0] * acc[(g) >> 2][bj][(g) & 3][0], v1 = srcv[bj][1] + gv[bj][1] * acc[(g) >> 2][bj][(g) & 3][1]; \
                acc[(g) >> 2][bj][(g) & 3][0] = v0; acc[(g) >> 2][bj][(g) & 3][1] = v1; \
                s_ += (v0[0] * v0[0] + v0[1] * v0[1]) + (v0[2] * v0[2] + v0[3] * v0[3]) + (v1[0] * v1[0] + v1[1] * v1[1]) + (v1[2] * v1[2] + v1[3] * v1[3]); \
                u32x4 w; w.x = pk_bf16(v0[0], v0[1]); w.y = pk_bf16(v0[2], v0[3]); w.z = pk_bf16(v1[0], v1[1]); w.w = pk_bf16(v1[2], v1[3]); *(u32x4*)((char*)x1 + (off_ + bj * HALF) * 2u) = w; } ps[g] = s_; } while (0)
            EN_LOAD(xa, 0);
#pragma unroll
            for (int g = 0; g < 8; g += 2) {
                EN_LOAD(xb2, g + 1);
                asm volatile("" ::: "memory");
                EN_STORE(xa, g);
                if (g + 2 < 8) EN_LOAD(xa, g + 2);
                asm volatile("" ::: "memory");
                EN_STORE(xb2, g + 1);
            }
#undef EN_LOAD
#undef EN_STORE
        }
#pragma unroll
        for (int g = 0; g < 8; ++g) { ps[g] += __shfl_xor(ps[g], 16); ps[g] += __shfl_xor(ps[g], 32); }
        LAS float* P = (LAS float*)lx; LAS float* S = P + 1024;
        if (fq == 0) {
#pragma unroll
            for (int g = 0; g < 8; ++g) P[((g >> 2) * HALF + wr * 64 + (g & 3) * 16 + fr) * 4 + wc] = ps[g]; }
        asm volatile("s_waitcnt lgkmcnt(0)" ::: "memory"); __builtin_amdgcn_s_barrier(); asm volatile("" ::: "memory");
        const int w = wr * 4 + wc, lane = fq * 16 + fr, prow = 32 * w + (lane & 31);
        float* slot = xb + ((size_t)(u.e * 128 + u.pm) * 256 + prow) * 4;
        unsigned* c = cnt + (size_t)(u.e * 128 + u.pm) * 64;
        if (lane < 32) { const float t = (P[prow * 4 + 0] + P[prow * 4 + 1]) + (P[prow * 4 + 2] + P[prow * 4 + 3]);
            __hip_atomic_store(slot + u.pn, t, __ATOMIC_RELAXED, __HIP_MEMORY_SCOPE_AGENT); }
        asm volatile("s_waitcnt vmcnt(0)" ::: "memory");
        if (lane == 0) __hip_atomic_fetch_add(c, 1u, __ATOMIC_RELAXED, __HIP_MEMORY_SCOPE_AGENT);
        if (w == 0) {
            unsigned spins = 0;
            while ((unsigned)__builtin_amdgcn_readfirstlane(__hip_atomic_load(c, __ATOMIC_RELAXED, __HIP_MEMORY_SCOPE_AGENT)) < 32u) { __builtin_amdgcn_s_sleep(2); if (++spins > (1u << 22)) break; }
            __builtin_amdgcn_fence(__ATOMIC_ACQUIRE, "agent");
            asm volatile("s_waitcnt vmcnt(0)" ::: "memory");
        }
        asm volatile("s_waitcnt lgkmcnt(0)" ::: "memory"); __builtin_amdgcn_s_barrier(); asm volatile("" ::: "memory");
        if (lane < 32) { const f32x4 s4 = load_sc1_x4(slot); const float t = (s4[0] + s4[1]) + (s4[2] + s4[3]);
            S[prow] = rsqrtf(t * (1.0f / DM) + NORM_EPS); }
        asm volatile("s_waitcnt lgkmcnt(0)" ::: "memory"); __builtin_amdgcn_s_barrier(); asm volatile("" ::: "memory");
#pragma unroll
        for (int bj = 0; bj < 2; ++bj) {
            f32x4 gm[2], sh[2];
#pragma unroll
            for (int n = 0; n < 2; ++n) { const int cc = col0 + bj * HALF + n * 4; gm[n] = *(const f32x4*)(g2 + cc) * (*(const f32x4*)(adab + 4096 + cc) + 1.0f); sh[n] = *(const f32x4*)(adab + 3072 + cc); }
#pragma unroll
            for (int g = 0; g < 8; ++g) { const int rl = (g >> 2) * HALF + wr * 64 + (g & 3) * 16 + fr; const float rs = S[rl];
                const f32x4 y0 = acc[g >> 2][bj][g & 3][0] * rs * gm[0] + sh[0], y1 = acc[g >> 2][bj][g & 3][1] * rs * gm[1] + sh[1];
                const unsigned off_ = (unsigned)((u.pm * BM + rl) * DM + col0 + bj * HALF);
                u32x4 wv; wv.x = pk_bf16(y0[0], y0[1]); wv.y = pk_bf16(y0[2], y0[3]); wv.z = pk_bf16(y1[0], y1[1]); wv.w = pk_bf16(y1[2], y1[3]);
                *(u32x4*)((char*)h2 + off_ * 2u) = wv;
                u32x2 w8; w8.x = pk4_fp8(y0[0], y0[1], y0[2], y0[3]); w8.y = pk4_fp8(y1[0], y1[1], y1[2], y1[3]);
                *(u32x2*)(h28 + off_) = w8; }
        }
    }
};
struct EpiPw2Norm {
    static constexpr bool PERM = true;
    const float* __restrict__ bias; const float* __restrict__ gc; bf16_t* __restrict__ mix; float* xb; unsigned* cnt; LAS unsigned char* lx;
    __device__ __forceinline__ void operator()(Acc& acc, const Unit& u, int wr, int wc, int fr, int fq) const {
        const int col0 = u.pn * BM + wc * 32 + 8 * fq;
        float ps[8];
        {
            f32x4 bv[2][2];
#pragma unroll
            for (int bj = 0; bj < 2; ++bj)
#pragma unroll
                for (int n = 0; n < 2; ++n) bv[bj][n] = *(const f32x4*)(bias + col0 + bj * HALF + 4 * n);
#pragma unroll
            for (int g = 0; g < 8; ++g) { float s_ = 0.f;
#pragma unroll
                for (int bj = 0; bj < 2; ++bj)
#pragma unroll
                    for (int n = 0; n < 2; ++n) { const f32x4 v = acc[g >> 2][bj][g & 3][n] + bv[bj][n]; acc[g >> 2][bj][g & 3][n] = v; s_ += (v[0] * v[0] + v[1] * v[1]) + (v[2] * v[2] + v[3] * v[3]); }
                ps[g] = s_; }
        }
#pragma unroll
        for (int g = 0; g < 8; ++g) { ps[g] += __shfl_xor(ps[g], 16); ps[g] += __shfl_xor(ps[g], 32); }
        LAS float* P = (LAS float*)lx; LAS float* S = P + 1024;
        if (fq == 0) {
#pragma unroll
            for (int g = 0; g < 8; ++g) P[((g >> 2) * HALF + wr * 64 + (g & 3) * 16 + fr) * 4 + wc] = ps[g]; }
        asm volatile("s_waitcnt lgkmcnt(0)" ::: "memory"); __builtin_amdgcn_s_barrier(); asm volatile("" ::: "memory");
        const int w = wr * 4 + wc, lane = fq * 16 + fr, prow = 32 * w + (lane & 31);
        float* slot = xb + ((size_t)u.pm * 256 + prow) * 2;
        unsigned* c = cnt + (size_t)u.pm * 64;
        if (lane < 32) { const float t = (P[prow * 4 + 0] + P[prow * 4 + 1]) + (P[prow * 4 + 2] + P[prow * 4 + 3]);
            __hip_atomic_store(slot + u.pn, t, __ATOMIC_RELAXED, __HIP_MEMORY_SCOPE_AGENT); }
        asm volatile("s_waitcnt vmcnt(0)" ::: "memory");
        if (lane == 0) __hip_atomic_fetch_add(c, 1u, __ATOMIC_RELAXED, __HIP_MEMORY_SCOPE_AGENT);
        if (w == 0) {
            unsigned spins = 0;
            while ((unsigned)__builtin_amdgcn_readfirstlane(__hip_atomic_load(c, __ATOMIC_RELAXED, __HIP_MEMORY_SCOPE_AGENT)) < 16u) { __builtin_amdgcn_s_sleep(2); if (++spins > (1u << 22)) break; }
            __builtin_amdgcn_fence(__ATOMIC_ACQUIRE, "agent");
            asm volatile("s_waitcnt vmcnt(0)" ::: "memory");
        }
        asm volatile("s_waitcnt lgkmcnt(0)" ::: "memory"); __builtin_amdgcn_s_barrier(); asm volatile("" ::: "memory");
        if (lane < 32) { const f32x2_t s2 = load_sc1_x2(slot); const float t = s2[0] + s2[1];
            S[prow] = rsqrtf(t * (1.0f / CW) + NORM_EPS); }
        asm volatile("s_waitcnt lgkmcnt(0)" ::: "memory"); __builtin_amdgcn_s_barrier(); asm volatile("" ::: "memory");
#pragma unroll
        for (int bj = 0; bj < 2; ++bj) {
            f32x4 gm[2];
#pragma unroll
            for (int n = 0; n < 2; ++n) gm[n] = *(const f32x4*)(gc + col0 + bj * HALF + n * 4);
#pragma unroll
            for (int g = 0; g < 8; ++g) { const int rl = (g >> 2) * HALF + wr * 64 + (g & 3) * 16 + fr; const float rs = S[rl];
                const f32x4 y0 = acc[g >> 2][bj][g & 3][0] * rs * gm[0], y1 = acc[g >> 2][bj][g & 3][1] * rs * gm[1];
                u32x4 wv; wv.x = pk_bf16(y0[0], y0[1]); wv.y = pk_bf16(y0[2], y0[3]); wv.z = pk_bf16(y1[0], y1[1]); wv.w = pk_bf16(y1[2], y1[3]);
                *(u32x4*)((char*)mix + (unsigned)(((u.pm * BM + rl) * DM + AW + col0 + bj * HALF) * 2)) = wv; }
        }
    }
};
struct EpiGU {
    static constexpr bool PERM = true;
    unsigned char* H;
    __device__ __forceinline__ void operator()(const Acc& acc, const Unit& u, int wr, int wc, int fr, int fq) const {
        const int row0 = u.pm + wr * 64 + fr, col0 = u.pn * 128 + wc * 32 + 8 * fq;
#pragma unroll
        for (int ai = 0; ai < 2; ++ai)
#pragma unroll
            for (int m = 0; m < 4; ++m) {
                float v[8];
#pragma unroll
                for (int j = 0; j < 4; ++j) { v[j] = silu_fast(acc[ai][0][m][0][j] * F8_WINV) * (acc[ai][1][m][0][j] * F8_WINV); v[4 + j] = silu_fast(acc[ai][0][m][1][j] * F8_WINV) * (acc[ai][1][m][1][j] * F8_WINV); }
                u32x2 w; w.x = pk4_fp8(v[0], v[1], v[2], v[3]); w.y = pk4_fp8(v[4], v[5], v[6], v[7]);
                *(u32x2*)(H + (size_t)(row0 + ai * HALF + m * 16) * FE + col0) = w;
            }
    }
};
struct EpiDown {
    static constexpr bool PERM = true;
    static constexpr bool PF = true;
    unsigned char* Y; LAS unsigned char* xch; const int* aids;
    __device__ __forceinline__ void pf_issue(int upm, int ukind, int par, int wr, int wc) const {
        int tz = threadIdx.x; asm volatile("" : "+v"(tz)); const int lane = tz & 63;
        const int row = upm + (wc & 1) * HALF + wr * 64 + lane;
        __builtin_amdgcn_global_load_lds((const unsigned*)(aids + (ukind == 0 ? row : lane)), (LAS unsigned*)(xch + 4 * 4352 + par * 1024 + wr * 512 + (wc & 1) * 256), 4, 0, 0);
    }
    __device__ __forceinline__ void operator()(const Acc& acc, const Unit& u, int wr, int wc, int fr, int fq, int par) const {
        const float sc = 16.0f * F8_WINV;
        const int lt = threadIdx.x & 255, rrow = lt >> 4, rc16 = lt & 15;
        const int wbyte = fr * 272 + wc * 32 + 8 * fq;
        static_assert((WS_H2F8 - WS_YBUF) % 1024 == 0, "dummy rows must be row-aligned");
        constexpr int DR0 = (int)((WS_H2F8 - WS_YBUF) / 1024);
        const LAS int* ib = (const LAS int*)(xch + 4 * 4352 + par * 1024 + wr * 512);
        const bool k0 = u.kind == 0;
        unsigned char* gbase = Y + u.pn * BM + 16 * rc16;
#pragma unroll
        for (int g = 0; g < 8; ++g) {
            const int ai = g >> 2, m = g & 3;
            LAS unsigned char* buf = xch + (wr * 2 + (g & 1)) * 4352;
#pragma unroll
            for (int bj = 0; bj < 2; ++bj) { const f32x4 v0 = acc[ai][bj][m][0] * sc, v1 = acc[ai][bj][m][1] * sc;
                u32x2 w; w.x = pk4_fp8(v0[0], v0[1], v0[2], v0[3]); w.y = pk4_fp8(v1[0], v1[1], v1[2], v1[3]);
                *(LAS u32x2*)(buf + wbyte + bj * HALF) = w; }
            const int aid = ib[ai * 64 + m * 16 + rrow], slot = u.pm + ai * HALF + wr * 64 + m * 16 + rrow;
            asm volatile("s_waitcnt lgkmcnt(0)" ::: "memory"); __builtin_amdgcn_s_barrier(); asm volatile("" ::: "memory");
            const u32x4 o = *(const LAS u32x4*)(buf + rrow * 272 + 16 * rc16);
            const int ya = aid < 0 ? DR0 + (slot & (NT - 1)) : aid + (aid >> 3), yb = (slot - NSLOT_MAX) * 9 + 8;
            *(u32x4*)(gbase + (size_t)(k0 ? ya : yb) * DM) = o;
        }
    }
};

struct Args {
    const float* in[26];
    float* out;
    unsigned char* ws;
    int ph_lo, ph_hi;
};
constexpr int NPHASE = 14;

__device__ __forceinline__ void transpose_job(LAS unsigned* T, const float* srcA, const float* srcB, int ldsrc, bf16_t* dst, int lddst) {
    const int tid = threadIdx.x, lane = tid & 63, w = tid >> 6;
    const float* src = (lane < 32) ? (srcA + 4 * lane) : (srcB + 4 * (lane - 32));
    f32x4 v0[4], v1[4];
#pragma unroll
    for (int i = 0; i < 4; ++i) { const int k0 = 2 * w + 16 * i; v0[i] = *(const f32x4*)(src + (size_t)k0 * ldsrc); v1[i] = *(const f32x4*)(src + (size_t)(k0 + 1) * ldsrc); }
#pragma unroll
    for (int i = 0; i < 4; ++i)
#pragma unroll
        for (int j = 0; j < 4; ++j) T[(j * 64 + lane) * 33 + (w + 8 * i)] = pk_bf16(v0[i][j], v1[i][j]);
    __syncthreads();
#pragma unroll
    for (int q = 0; q < 4; ++q) { const int n = (tid >> 3) + 64 * q, kc = tid & 7, rho = (n & 3) * 64 + (n >> 2);
        u32x4 o; o.x = T[rho * 33 + kc * 4 + 0]; o.y = T[rho * 33 + kc * 4 + 1]; o.z = T[rho * 33 + kc * 4 + 2]; o.w = T[rho * 33 + kc * 4 + 3];
        *(u32x4*)(dst + (size_t)n * lddst + kc * 8) = o; }
    __syncthreads();
}
struct F8Job { const float* a; const float* b; int ld; unsigned char* dst; int ldd; };
__device__ __forceinline__ void f8job_load(const F8Job& J, f32x4 (&v)[4][4]) {
    const int lane = threadIdx.x & 63, w = threadIdx.x >> 6;
    const float* src = (lane < 32) ? (J.a + 4 * lane) : (J.b + 4 * (lane - 32));
#pragma unroll
    for (int i = 0; i < 4; ++i)
#pragma unroll
        for (int kk = 0; kk < 4; ++kk) v[i][kk] = *(const f32x4*)(src + (size_t)(4 * w + 32 * i + kk) * J.ld);
}
__device__ __forceinline__ void f8job_park(LAS unsigned* T, const f32x4 (&v)[4][4], float sc) {
    const int lane = threadIdx.x & 63, w = threadIdx.x >> 6;
#pragma unroll
    for (int i = 0; i < 4; ++i)
#pragma unroll
        for (int j = 0; j < 4; ++j) T[(j * 64 + lane) * 33 + (w + 8 * i)] = pk4_fp8(v[i][0][j] * sc, v[i][1][j] * sc, v[i][2][j] * sc, v[i][3][j] * sc);
}
__device__ __forceinline__ void f8job_store(const LAS unsigned* T, const F8Job& J) {
    const int tid = threadIdx.x;
#pragma unroll
    for (int q = 0; q < 4; ++q) { const int n = (tid >> 3) + 64 * q, kc = tid & 7, rho = (n & 3) * 64 + (n >> 2);
        u32x4 o; o.x = T[rho * 33 + kc * 4 + 0]; o.y = T[rho * 33 + kc * 4 + 1]; o.z = T[rho * 33 + kc * 4 + 2]; o.w = T[rho * 33 + kc * 4 + 3];
        *(u32x4*)(J.dst + (size_t)n * J.ldd + kc * 16) = o; }
}
constexpr int JOBS_GU = 257 * 16, JOBS_DN = 257 * 8, JOBS_F8 = JOBS_GU + JOBS_DN, JOBS_IN = 160, JOBS_OUT = 64, JOBS_PW2 = 16, JOBS_R = 16;
constexpr int JOBS_BF = JOBS_IN + JOBS_OUT + JOBS_PW2 + JOBS_R;

__device__ __forceinline__ void convert_f8_jobs(const Args& a, LAS unsigned char* lds, int jlo, int jhi, int k, int nk) {
    unsigned char* ws = a.ws; LAS unsigned* T = (LAS unsigned*)lds;
    const float* wg = a.in[19]; const float* wu = a.in[20]; const float* wd = a.in[21];
    const float* sg = a.in[22]; const float* su = a.in[23]; const float* sd = a.in[24];
    auto decode = [&](int j) -> F8Job { F8Job J;
        if (j < JOBS_GU) { const int e = j >> 4, r = j & 15, h = r >> 3, k0 = (r & 7) * 128;
            const float* ge = (e < NEXP) ? wg + (size_t)e * DM * FE : sg; const float* ue = (e < NEXP) ? wu + (size_t)e * DM * FE : su;
            J.a = ge + (size_t)k0 * FE + 128 * h; J.b = ue + (size_t)k0 * FE + 128 * h; J.ld = FE; J.dst = (unsigned char*)(ws + WS_WGU) + (size_t)(e * 2 + h) * 256 * DM + k0; J.ldd = DM;
        } else { const int jj = j - JOBS_GU, e = jj >> 3, r = jj & 7, n0 = (r >> 1) * 256, k0 = (r & 1) * 128;
            const float* de = (e < NEXP) ? wd + (size_t)e * FE * DM : sd;
            J.a = de + (size_t)k0 * DM + n0; J.b = J.a + 128; J.ld = DM; J.dst = (unsigned char*)(ws + WS_WDT) + ((size_t)e * DM + n0) * FE + k0; J.ldd = FE; }
        return J; };
    if (jlo + k < jhi) {
        f32x4 va[4][4], vb[4][4];
        F8Job ja = decode(jlo + k), jb = ja; f8job_load(ja, va);
        if (jlo + k + nk < jhi) { jb = decode(jlo + k + nk); f8job_load(jb, vb); }
        for (int j = jlo + k; j < jhi; j += 2 * nk) {
            { f8job_park(T, va, F8_WSCALE); const F8Job cur = ja; const int jn = j + 2 * nk; if (jn < jhi) { ja = decode(jn); f8job_load(ja, va); }
              __syncthreads(); f8job_store(T, cur); __syncthreads(); }
            if (j + nk < jhi) { f8job_park(T, vb, F8_WSCALE); const F8Job cur = jb; const int jn = j + 3 * nk; if (jn < jhi) { jb = decode(jn); f8job_load(jb, vb); }
              __syncthreads(); f8job_store(T, cur); __syncthreads(); }
        }
    }
}

__device__ __forceinline__ void p0_prologue(const Args& a, LAS unsigned char* lds) {
    const int tid = threadIdx.x, G = gridDim.x, bx = blockIdx.x;
    unsigned char* ws = a.ws;
    {
        LAS float* sl = (LAS float*)lds;
        LAS float* red = (LAS float*)(lds + 16384);
        const float* c = a.in[1]; const float* w_ada = a.in[4]; const float* b_ada = a.in[5];
        float* ada = (float*)(ws + WS_ADA);
        for (int i = tid; i < NB * DM; i += 512) sl[i] = silu_fast(c[i]);
        __syncthreads();
        for (int ci = bx; ci < 256; ci += G) {
            if (tid < 384) {
                const int q = tid % 6, ks = tid / 6, n = 24 * ci + 4 * q;
                f32x4 ac[4];
#pragma unroll
                for (int b = 0; b < 4; ++b) ac[b] = (f32x4){0.f, 0.f, 0.f, 0.f};
#pragma unroll
                for (int kk = 0; kk < 16; ++kk) { const int k = ks * 16 + kk; const f32x4 w4 = *(const f32x4*)(w_ada + (size_t)k * 6144 + n);
#pragma unroll
                    for (int b = 0; b < 4; ++b) ac[b] += w4 * sl[b * 1024 + k]; }
#pragma unroll
                for (int b = 0; b < 4; ++b)
#pragma unroll
                    for (int j = 0; j < 4; ++j) red[tid * 16 + b * 4 + j] = ac[b][j];
            }
            __syncthreads();
            if (tid < 96) { const int b = tid / 24, col = tid % 24, q = col >> 2, j = col & 3; float s = 0.f;
                for (int ks = 0; ks < 64; ++ks) s += red[(ks * 6 + q) * 16 + b * 4 + j];
                ada[(size_t)b * 6144 + 24 * ci + col] = s + b_ada[24 * ci + col]; }
            __syncthreads();
        }
    }
    {
        const int* pos = (const int*)a.in[2]; float* rope = (float*)(ws + WS_ROPE);
        for (int id = bx * 512 + tid; id < NT * 8; id += G * 512) { const int t = id >> 3, i = id & 7;
            const double invf = i == 0 ? 1.0 : i == 1 ? 0.19392274474868576 : i == 2 ? 0.03760603093086393 : i == 3 ? 0.007292664737217109
                              : i == 4 ? 0.001414213562373095 : i == 5 ? 0.0002742481756762073 : i == 6 ? 5.318295896944988e-05 : 1.031338537721246e-05;
            const double rev = (double)pos[t] * invf * 0.15915494309189535; const float fr = (float)(rev - __builtin_rint(rev));
            rope[(size_t)t * 16 + i] = __builtin_amdgcn_cosf(fr); rope[(size_t)t * 16 + 8 + i] = __builtin_amdgcn_sinf(fr); }
    }
    {
        LAS unsigned* T = (LAS unsigned*)lds;
        const float* w_in = a.in[6]; const float* w_pw2 = a.in[11]; const float* w_out = a.in[15]; const float* w_r = a.in[17];
        const float* wg = a.in[19]; const float* wu = a.in[20]; const float* wd = a.in[21];
        const float* sg = a.in[22]; const float* su = a.in[23]; const float* sd = a.in[24];
        for (int j = bx; j < JOBS_BF; j += G) {
            const float* sA; const float* sB; int ld; bf16_t* dst; int ldd;
            if (j < JOBS_IN) { const int pn = j >> 4, k0 = (j & 15) * 64;
                if (pn < 6) { sA = w_in + (size_t)k0 * NPROJ + 256 * pn; sB = sA + 128; }
                else { sA = w_in + (size_t)k0 * NPROJ + 1536 + 128 * (pn - 6); sB = w_in + (size_t)k0 * NPROJ + 2048 + 128 * (pn - 6); }
                ld = NPROJ; dst = (bf16_t*)(ws + WS_WIN) + (size_t)pn * 256 * DM + k0; ldd = DM;
            } else if (j < JOBS_IN + JOBS_OUT) { const int jj = j - JOBS_IN, pn = jj >> 4, k0 = (jj & 15) * 64;
                sA = w_out + (size_t)k0 * DM + 256 * pn; sB = sA + 128; ld = DM; dst = (bf16_t*)(ws + WS_WOUT) + (size_t)pn * 256 * DM + k0; ldd = DM;
            } else if (j < JOBS_IN + JOBS_OUT + JOBS_PW2) { const int jj = j - JOBS_IN - JOBS_OUT, pn = jj >> 3, k0 = (jj & 7) * 64;
                sA = w_pw2 + (size_t)k0 * CW + 256 * pn; sB = sA + 128; ld = CW; dst = (bf16_t*)(ws + WS_WPW2) + (size_t)pn * 256 * CW + k0; ldd = CW;
            } else { const int jj = j - JOBS_IN - JOBS_OUT - JOBS_PW2, k0 = jj * 64;
                sA = w_r + (size_t)k0 * NEXP; sB = sA + 128; ld = NEXP; dst = (bf16_t*)(ws + WS_WR) + k0; ldd = DM; }
            transpose_job(T, sA, sB, ld, dst, ldd);
        }
        if (G != 256) convert_f8_jobs(a, lds, 0, JOBS_F8, bx, G);
    }
}

__device__ __forceinline__ void normmod_phase(const float* X, const float* g, const float* sh, const float* sc, bf16_t* H) {
    const int lane = threadIdx.x & 63, wave = threadIdx.x >> 6;
    f32x4 gv[4];
#pragma unroll
    for (int j = 0; j < 4; ++j) gv[j] = *(const f32x4*)(g + 4 * lane + 256 * j);
    for (int row = (blockIdx.x * 8 + wave) * 2; row < NT; row += gridDim.x * 16) {
        const int b = row >> 13;
        f32x4 xv[2][4]; float ss[2] = {0.f, 0.f};
#pragma unroll
        for (int r = 0; r < 2; ++r)
#pragma unroll
            for (int j = 0; j < 4; ++j) xv[r][j] = *(const f32x4*)(X + (size_t)(row + r) * DM + 4 * lane + 256 * j);
        f32x4 sv[4], hv[4];
#pragma unroll
        for (int j = 0; j < 4; ++j) { const int col = 4 * lane + 256 * j; sv[j] = *(const f32x4*)(sc + (size_t)b * 6144 + col); hv[j] = *(const f32x4*)(sh + (size_t)b * 6144 + col); }
#pragma unroll
        for (int r = 0; r < 2; ++r) {
#pragma unroll
            for (int j = 0; j < 4; ++j) ss[r] += xv[r][j][0] * xv[r][j][0] + xv[r][j][1] * xv[r][j][1] + xv[r][j][2] * xv[r][j][2] + xv[r][j][3] * xv[r][j][3];
            ss[r] = wave_sum(ss[r]); }
#pragma unroll
        for (int r = 0; r < 2; ++r) { const float rstd = rsqrtf(ss[r] * (1.0f / DM) + NORM_EPS);
#pragma unroll
            for (int j = 0; j < 4; ++j) { const int col = 4 * lane + 256 * j;
                const f32x4 y = (xv[r][j] * rstd) * gv[j] * (sv[j] + 1.0f) + hv[j];
                u32x2 w; w.x = pk_bf16(y[0], y[1]); w.y = pk_bf16(y[2], y[3]);
                *(u32x2*)(H + (size_t)(row + r) * DM + col) = w; } }
    }
}

__device__ __forceinline__ void normmod_bf16_phase(const bf16_t* X, const float* g, const float* sh, const float* sc, bf16_t* H, unsigned char* H8) {
    const int lane = threadIdx.x & 63, wave = threadIdx.x >> 6;
    for (int row = blockIdx.x * 8 + wave; row < NT; row += gridDim.x * 8) {
        const int b = row >> 13;
        float v[2][8]; float ss = 0.f;
#pragma unroll
        for (int j = 0; j < 2; ++j) { const u32x4 w = *(const u32x4*)(X + (size_t)row * DM + 8 * lane + 512 * j);
            v[j][0] = bf_lo(w.x); v[j][1] = bf_hi(w.x); v[j][2] = bf_lo(w.y); v[j][3] = bf_hi(w.y); v[j][4] = bf_lo(w.z); v[j][5] = bf_hi(w.z); v[j][6] = bf_lo(w.w); v[j][7] = bf_hi(w.w);
#pragma unroll
            for (int i = 0; i < 8; ++i) ss += v[j][i] * v[j][i]; }
        ss = wave_sum(ss);
        const float rstd = rsqrtf(ss * (1.0f / DM) + NORM_EPS);
#pragma unroll
        for (int j = 0; j < 2; ++j) { const int col = 8 * lane + 512 * j; float y[8];
#pragma unroll
            for (int q = 0; q < 2; ++q) { const f32x4 gv = *(const f32x4*)(g + col + 4 * q), sv = *(const f32x4*)(sc + (size_t)b * 6144 + col + 4 * q), hv = *(const f32x4*)(sh + (size_t)b * 6144 + col + 4 * q);
#pragma unroll
                for (int i = 0; i < 4; ++i) y[4 * q + i] = (v[j][4 * q + i] * rstd) * gv[i] * (sv[i] + 1.0f) + hv[i]; }
            u32x4 w; w.x = pk_bf16(y[0], y[1]); w.y = pk_bf16(y[2], y[3]); w.z = pk_bf16(y[4], y[5]); w.w = pk_bf16(y[6], y[7]);
            *(u32x4*)(H + (size_t)row * DM + col) = w;
            u32x2 w8; w8.x = pk4_fp8(y[0], y[1], y[2], y[3]); w8.y = pk4_fp8(y[4], y[5], y[6], y[7]);
            *(u32x2*)(H8 + (size_t)row * DM + col) = w8; }
    }
}

__device__ __forceinline__ void attn_naive_unit(int unit, const bf16_t* Q, const bf16_t* Kb, const bf16_t* Vb, bf16_t* O, float* LSE) {
    const int lane = threadIdx.x & 63, head = threadIdx.x >> 6;
    const int t = unit * 64 + lane, b = t >> 13, s = t & (SEQ - 1);
    const size_t hb = (size_t)(b * NHEAD + head) * SEQ;
    float q[64];
    { const u32x4* qp = (const u32x4*)(Q + (hb + s) * HD);
#pragma unroll
      for (int c = 0; c < 8; ++c) { const u32x4 w = qp[c]; q[8 * c + 0] = bf_lo(w.x); q[8 * c + 1] = bf_hi(w.x); q[8 * c + 2] = bf_lo(w.y); q[8 * c + 3] = bf_hi(w.y); q[8 * c + 4] = bf_lo(w.z); q[8 * c + 5] = bf_hi(w.z); q[8 * c + 6] = bf_lo(w.w); q[8 * c + 7] = bf_hi(w.w); } }
    for (int br = 0; br < 3; ++br) {
        const int d = (br == 0) ? 1 : (br == 1 ? 4 : 16);
        float mx = -1e30f, l = 0.f; float o[64];
#pragma unroll
        for (int i = 0; i < 64; ++i) o[i] = 0.f;
        for (int j = 0; j <= 128; ++j) {
            const int p = s - j * d; if (p < 0) break;
            const u32x4* kp = (const u32x4*)(Kb + (hb + p) * HD);
            float sc = 0.f;
#pragma unroll
            for (int c = 0; c < 8; ++c) { const u32x4 w = kp[c];
                sc += q[8 * c + 0] * bf_lo(w.x) + q[8 * c + 1] * bf_hi(w.x) + q[8 * c + 2] * bf_lo(w.y) + q[8 * c + 3] * bf_hi(w.y) + q[8 * c + 4] * bf_lo(w.z) + q[8 * c + 5] * bf_hi(w.z) + q[8 * c + 6] * bf_lo(w.w) + q[8 * c + 7] * bf_hi(w.w); }
            const float mn = fmaxf(mx, sc), al = __expf(mx - mn), pe = __expf(sc - mn);
            l = l * al + pe; mx = mn;
            const u32x4* vp = (const u32x4*)(Vb + (hb + p) * HD);
#pragma unroll
            for (int c = 0; c < 8; ++c) { const u32x4 w = vp[c];
                o[8 * c + 0] = o[8 * c + 0] * al + pe * bf_lo(w.x); o[8 * c + 1] = o[8 * c + 1] * al + pe * bf_hi(w.x);
                o[8 * c + 2] = o[8 * c + 2] * al + pe * bf_lo(w.y); o[8 * c + 3] = o[8 * c + 3] * al + pe * bf_hi(w.y);
                o[8 * c + 4] = o[8 * c + 4] * al + pe * bf_lo(w.z); o[8 * c + 5] = o[8 * c + 5] * al + pe * bf_hi(w.z);
                o[8 * c + 6] = o[8 * c + 6] * al + pe * bf_lo(w.w); o[8 * c + 7] = o[8 * c + 7] * al + pe * bf_hi(w.w); }
        }
        const float inv = 1.0f / l;
        u32x4* op = (u32x4*)(O + ((size_t)br * NT + t) * AW + head * HD);
#pragma unroll
        for (int c = 0; c < 8; ++c) { u32x4 w; w.x = pk_bf16(o[8 * c + 0] * inv, o[8 * c + 1] * inv); w.y = pk_bf16(o[8 * c + 2] * inv, o[8 * c + 3] * inv); w.z = pk_bf16(o[8 * c + 4] * inv, o[8 * c + 5] * inv); w.w = pk_bf16(o[8 * c + 6] * inv, o[8 * c + 7] * inv); op[c] = w; }
        LSE[((size_t)br * NT + t) * NHEAD + head] = mx + __logf(l);
    }
}


typedef float f32x16 __attribute__((ext_vector_type(16)));
typedef short v4i16_t __attribute__((ext_vector_type(4)));
template <int AM = 0>
__device__ __forceinline__ void attn_unit(int unit, LAS unsigned char* lds, const bf16_t* Q, const bf16_t* Kb, const bf16_t* Vb, bf16_t* O, float* LSE) {
    const int tid = threadIdx.x, lane = tid & 63, w = __builtin_amdgcn_readfirstlane(tid >> 6), r32 = lane & 31, hi = lane >> 5;
    const int blk = unit & 31, rest = unit >> 5, br = rest % 3, bh = rest / 3;
    const int dsh = 2 * br, nper = 32 >> dsh, res = blk / nper, mblk = blk & (nper - 1), m0 = mblk * 256;
    const size_t hb = (size_t)bh * SEQ;
    u32x4 vst[6];
#pragma unroll
    for (int it = 0; it < 6; ++it) { const int cidx = tid + 512 * it, row = cidx >> 3, c = cidx & 7; int kidx = m0 - 128 + row; kidx = kidx < 0 ? 0 : kidx;
        vst[it] = *(const u32x4*)(Vb + (hb + ((size_t)kidx << dsh) + res) * HD + 8 * c); }
    const int qm = m0 + 32 * w + r32; const size_t qpos = ((size_t)qm << dsh) + res;
    bf16x8 qf[4];
#pragma unroll
    for (int s = 0; s < 4; ++s) qf[s] = *(const bf16x8*)(Q + (hb + qpos) * HD + 16 * s + 8 * hi);
    {
        u32x4 kst[6];
#pragma unroll
        for (int it = 0; it < 6; ++it) { const int cidx = tid + 512 * it, row = cidx >> 3, c = cidx & 7; int kidx = m0 - 128 + row; kidx = kidx < 0 ? 0 : kidx;
            kst[it] = *(const u32x4*)(Kb + (hb + ((size_t)kidx << dsh) + res) * HD + 8 * c); }
#pragma unroll
        for (int it = 0; it < 6; ++it) { const int cidx = tid + 512 * it, row = cidx >> 3, c = cidx & 7;
            *(LAS u32x4*)(lds + 49152 + row * 128 + 16 * (c ^ ((row >> 1) & 7))) = kst[it]; }
#pragma unroll
        for (int it = 0; it < 6; ++it) { const int cidx = tid + 512 * it, row = cidx >> 3, c = cidx & 7;
            *(LAS u32x4*)(lds + row * 128 + ((16 * c) ^ (((row >> 1) & 1) << 6))) = vst[it]; }
    }
    __syncthreads();
    f32x16 S[5];
    const int kswz = (r32 >> 1) & 7;
#pragma unroll
    for (int i = 0; i < 5; ++i) {
        const LAS unsigned char* kr = lds + 49152 + (32 * w + 32 * i + r32) * 128;
        bf16x8 kf[4];
#pragma unroll
        for (int s = 0; s < 4; ++s) kf[s] = *(const LAS bf16x8*)(kr + 16 * ((2 * s + hi) ^ kswz));
        f32x16 c = {0.f, 0.f, 0.f, 0.f, 0.f, 0.f, 0.f, 0.f, 0.f, 0.f, 0.f, 0.f, 0.f, 0.f, 0.f, 0.f};
#pragma unroll
        for (int s = 0; s < 4; ++s) c = __builtin_amdgcn_mfma_f32_32x32x16_bf16(kf[s], qf[s], c, 0, 0, 0);
        S[i] = c;
    }
    if constexpr (AM == 1) { _Pragma("unroll") for (int i = 0; i < 5; ++i) asm volatile("" :: "v"(S[i])); __syncthreads(); return; }
    float mx = -3e38f;
#pragma unroll
    for (int i = 0; i < 5; ++i) {
        const bool tile_ok = (mblk > 0) || (w + i >= 4);
#pragma unroll
        for (int r = 0; r < 16; ++r) { const int kl = (r & 3) + 8 * (r >> 2) + 4 * hi;
            bool ok = tile_ok; if (i == 0) ok = ok && (kl >= r32); if (i == 4) ok = ok && (kl <= r32);
            const float v = ok ? S[i][r] : -3e38f; S[i][r] = v; mx = fmaxf(mx, v); }
    }
    mx = fmaxf(mx, __shfl_xor(mx, 32));
    const float nm = -mx * 1.4426950408889634f;
    float l = 0.f;
#pragma unroll
    for (int i = 0; i < 5; ++i)
#pragma unroll
        for (int r = 0; r < 16; ++r) { const float p = __builtin_amdgcn_exp2f(__builtin_fmaf(S[i][r], 1.4426950408889634f, nm)); S[i][r] = p; l += p; }
    l += __shfl_xor(l, 32);
    if constexpr (AM == 2) { _Pragma("unroll") for (int i = 0; i < 5; ++i) asm volatile("" :: "v"(S[i])); asm volatile("" :: "v"(l), "v"(mx)); __syncthreads(); return; }
    f32x16 o0 = {0.f, 0.f, 0.f, 0.f, 0.f, 0.f, 0.f, 0.f, 0.f, 0.f, 0.f, 0.f, 0.f, 0.f, 0.f, 0.f}, o1 = o0;
    const int qq = (lane & 15) >> 2, pp = lane & 3, g1 = (lane >> 4) & 1;
    const int vb0 = (4 * hi + qq) * 128 + ((32 * g1 + 8 * pp) ^ (((qq >> 1) & 1) << 6)), vb1 = vb0 ^ 64;
#pragma unroll
    for (int i = 0; i < 5; ++i)
#pragma unroll
        for (int s2 = 0; s2 < 2; ++s2) {
            u32x4 pw; pw.x = pk_bf16(S[i][8 * s2 + 0], S[i][8 * s2 + 1]); pw.y = pk_bf16(S[i][8 * s2 + 2], S[i][8 * s2 + 3]); pw.z = pk_bf16(S[i][8 * s2 + 4], S[i][8 * s2 + 5]); pw.w = pk_bf16(S[i][8 * s2 + 6], S[i][8 * s2 + 7]);
            const bf16x8 pf = __builtin_bit_cast(bf16x8, pw);
            const int rowoff = (32 * w + 32 * i + 16 * s2) * 128;
            const v4i16_t a0 = __builtin_amdgcn_ds_read_tr16_b64_v4i16((LAS v4i16_t*)(lds + vb0 + rowoff)), a1 = __builtin_amdgcn_ds_read_tr16_b64_v4i16((LAS v4i16_t*)(lds + vb0 + rowoff + 1024));
            const v4i16_t b0 = __builtin_amdgcn_ds_read_tr16_b64_v4i16((LAS v4i16_t*)(lds + vb1 + rowoff)), b1 = __builtin_amdgcn_ds_read_tr16_b64_v4i16((LAS v4i16_t*)(lds + vb1 + rowoff + 1024));
            const bf16x8 vf0 = (bf16x8){a0[0], a0[1], a0[2], a0[3], a1[0], a1[1], a1[2], a1[3]}, vf1 = (bf16x8){b0[0], b0[1], b0[2], b0[3], b1[0], b1[1], b1[2], b1[3]};
            o0 = __builtin_amdgcn_mfma_f32_32x32x16_bf16(vf0, pf, o0, 0, 0, 0);
            o1 = __builtin_amdgcn_mfma_f32_32x32x16_bf16(vf1, pf, o1, 0, 0, 0);
        }
    if constexpr (AM == 3) { asm volatile("" :: "v"(o0), "v"(o1), "v"(l), "v"(mx)); __syncthreads(); return; }
    const float inv = 1.0f / l;
    const int head = bh & 7, b = bh >> 3; const size_t t = (size_t)b * SEQ + qpos;
    {
        LAS unsigned char* stg = lds + 98304 + w * 4352;
#pragma unroll
        for (int g = 0; g < 4; ++g) {
            u32x2 w0; w0.x = pk_bf16(o0[4 * g + 0] * inv, o0[4 * g + 1] * inv); w0.y = pk_bf16(o0[4 * g + 2] * inv, o0[4 * g + 3] * inv); *(LAS u32x2*)(stg + r32 * 136 + 2 * (8 * g + 4 * hi)) = w0;
            u32x2 w1; w1.x = pk_bf16(o1[4 * g + 0] * inv, o1[4 * g + 1] * inv); w1.y = pk_bf16(o1[4 * g + 2] * inv, o1[4 * g + 3] * inv); *(LAS u32x2*)(stg + r32 * 136 + 2 * (32 + 8 * g + 4 * hi)) = w1;
        }
        asm volatile("s_waitcnt lgkmcnt(0)" ::: "memory");
        const size_t tq0 = (size_t)b * SEQ + (((size_t)(m0 + 32 * w) << dsh) + res);
#pragma unroll
        for (int i = 0; i < 4; ++i) { const int rq = i * 8 + (lane >> 3), ch = lane & 7;
            const u32x2 lo = *(const LAS u32x2*)(stg + rq * 136 + 16 * ch), hi2 = *(const LAS u32x2*)(stg + rq * 136 + 16 * ch + 8);
            u32x4 ov; ov.x = lo.x; ov.y = lo.y; ov.z = hi2.x; ov.w = hi2.y;
            *(u32x4*)(O + ((size_t)br * NT + tq0 + ((size_t)rq << dsh)) * AW + head * HD + 8 * ch) = ov; }
    }
    if (hi == 0) LSE[((size_t)br * NT + t) * NHEAD + head] = mx + __logf(l);
    __syncthreads();
}

__device__ __forceinline__ void conv_stage(int unit, LAS unsigned char* Aw, const bf16_t* Ab) {
    const int lane = threadIdx.x & 63, wave = threadIdx.x >> 6; const int t0 = unit * 32, s0 = t0 & (SEQ - 1);
    for (int r = wave; r < 62; r += 8) { const int s = s0 - 30 + r; const int tt = (s >= 0) ? (t0 - 30 + r) : (t0 - s0);
        __builtin_amdgcn_global_load_lds((const unsigned*)((const char*)Ab + (size_t)tt * (CW * 2) + lane * 16), (LAS unsigned*)(Aw + r * 1024), 16, 0, 0); }
}
__device__ __forceinline__ void conv_unit(int unit, int next_unit, LAS unsigned char* lds, const bf16_t* Ab, const float (&wv)[CONVK], float bd, const float* ln_g, const float* ln_b, bf16_t* Z) {
    const int tid = threadIdx.x, lane = tid & 63, wave = tid >> 6;
    const int t0 = unit * 32, s0 = t0 & (SEQ - 1);
    LAS float* Y = (LAS float*)lds;
    {
        const int c = tid;
        LAS unsigned char* Aw = lds + 65536;
        asm volatile("s_waitcnt vmcnt(0)" ::: "memory");
        __syncthreads();
        f32x2 P[46];
#pragma unroll
        for (int k = 0; k < 46; ++k) { const int sa = s0 - 30 + k, sb2 = sa + 16;
            const float la = __uint_as_float((unsigned)(*(const LAS unsigned short*)(Aw + k * 1024 + c * 2)) << 16), lb = __uint_as_float((unsigned)(*(const LAS unsigned short*)(Aw + (k + 16) * 1024 + c * 2)) << 16);
            P[k][0] = (sa >= 0) ? la : 0.f; P[k][1] = (sb2 >= 0) ? lb : 0.f; }
#pragma unroll
        for (int i = 0; i < 16; ++i) { f32x2 y = (f32x2){bd, bd};
#pragma unroll
            for (int j = 0; j < CONVK; ++j) { const f32x2 w2 = (f32x2){wv[j], wv[j]}; y = __builtin_elementwise_fma(w2, P[i + j], y); }
            Y[i * CW + c] = y[0]; Y[(i + 16) * CW + c] = y[1]; }
    }
    __syncthreads();
    if (next_unit >= 0) conv_stage(next_unit, lds + 65536, Ab);
#pragma unroll
    for (int r = 0; r < 4; ++r) {
        const int i = wave * 4 + r;
        const f32x4 y0 = *(const LAS f32x4*)(Y + i * CW + 8 * lane), y1 = *(const LAS f32x4*)(Y + i * CW + 8 * lane + 4);
        float sm = (y0[0] + y0[1]) + (y0[2] + y0[3]) + (y1[0] + y1[1]) + (y1[2] + y1[3]);
        sm = wave_sum(sm);
        const float mu = sm * (1.0f / CW);
        const f32x4 d0 = y0 - mu, d1 = y1 - mu;
        float vq = (d0[0] * d0[0] + d0[1] * d0[1]) + (d0[2] * d0[2] + d0[3] * d0[3]) + (d1[0] * d1[0] + d1[1] * d1[1]) + (d1[2] * d1[2] + d1[3] * d1[3]);
        vq = wave_sum(vq);
        const float rstd = rsqrtf(vq * (1.0f / CW) + NORM_EPS);
        const f32x4 g0 = *(const f32x4*)(ln_g + 8 * lane), g1 = *(const f32x4*)(ln_g + 8 * lane + 4), b0 = *(const f32x4*)(ln_b + 8 * lane), b1 = *(const f32x4*)(ln_b + 8 * lane + 4);
        f32x4 z0 = d0 * rstd * g0 + b0, z1 = d1 * rstd * g1 + b1;
#pragma unroll
        for (int j = 0; j < 4; ++j) { z0[j] = silu_fast(z0[j]); z1[j] = silu_fast(z1[j]); }
        u32x4 w; w.x = pk_bf16(z0[0], z0[1]); w.y = pk_bf16(z0[2], z0[3]); w.z = pk_bf16(z1[0], z1[1]); w.w = pk_bf16(z1[2], z1[3]);
        *(u32x4*)(Z + (size_t)(t0 + i) * CW + 8 * lane) = w;
    }
    __syncthreads();
}

__device__ __forceinline__ void mix_phase(const bf16_t* O, const float* LSE, const bf16_t* CR, const float* g_a, const float* g_c, bf16_t* MIX) {
    const int lane = threadIdx.x & 63, wave = threadIdx.x >> 6, head = lane >> 3;
    for (int t = blockIdx.x * 8 + wave; t < NT; t += gridDim.x * 8) {
        float l0 = LSE[((size_t)0 * NT + t) * NHEAD + head], l1 = LSE[((size_t)1 * NT + t) * NHEAD + head], l2 = LSE[((size_t)2 * NT + t) * NHEAD + head];
        const float mm = fmaxf(l0, fmaxf(l1, l2));
        float w0 = __expf(l0 - mm), w1 = __expf(l1 - mm), w2 = __expf(l2 - mm); const float inv = 1.0f / (w0 + w1 + w2); w0 *= inv; w1 *= inv; w2 *= inv;
        const u32x4 a0 = *(const u32x4*)(O + ((size_t)0 * NT + t) * AW + 8 * lane), a1 = *(const u32x4*)(O + ((size_t)1 * NT + t) * AW + 8 * lane), a2 = *(const u32x4*)(O + ((size_t)2 * NT + t) * AW + 8 * lane);
        float v[8];
        v[0] = w0 * bf_lo(a0.x) + w1 * bf_lo(a1.x) + w2 * bf_lo(a2.x); v[1] = w0 * bf_hi(a0.x) + w1 * bf_hi(a1.x) + w2 * bf_hi(a2.x);
        v[2] = w0 * bf_lo(a0.y) + w1 * bf_lo(a1.y) + w2 * bf_lo(a2.y); v[3] = w0 * bf_hi(a0.y) + w1 * bf_hi(a1.y) + w2 * bf_hi(a2.y);
        v[4] = w0 * bf_lo(a0.z) + w1 * bf_lo(a1.z) + w2 * bf_lo(a2.z); v[5] = w0 * bf_hi(a0.z) + w1 * bf_hi(a1.z) + w2 * bf_hi(a2.z);
        v[6] = w0 * bf_lo(a0.w) + w1 * bf_lo(a1.w) + w2 * bf_lo(a2.w); v[7] = w0 * bf_hi(a0.w) + w1 * bf_hi(a1.w) + w2 * bf_hi(a2.w);
        float ss = 0.f;
#pragma unroll
        for (int j = 0; j < 8; ++j) ss += v[j] * v[j];
        ss = wave_sum(ss);
        float rstd = rsqrtf(ss * (1.0f / AW) + NORM_EPS);
        { const f32x4 g0 = *(const f32x4*)(g_a + 8 * lane), g1 = *(const f32x4*)(g_a + 8 * lane + 4);
          u32x4 w; w.x = pk_bf16(v[0] * rstd * g0[0], v[1] * rstd * g0[1]); w.y = pk_bf16(v[2] * rstd * g0[2], v[3] * rstd * g0[3]); w.z = pk_bf16(v[4] * rstd * g1[0], v[5] * rstd * g1[1]); w.w = pk_bf16(v[6] * rstd * g1[2], v[7] * rstd * g1[3]);
          *(u32x4*)(MIX + (size_t)t * DM + 8 * lane) = w; }
        if (CR == nullptr) continue;
        const u32x4 c0 = *(const u32x4*)(CR + (size_t)t * CW + 8 * lane);
        v[0] = bf_lo(c0.x); v[1] = bf_hi(c0.x); v[2] = bf_lo(c0.y); v[3] = bf_hi(c0.y); v[4] = bf_lo(c0.z); v[5] = bf_hi(c0.z); v[6] = bf_lo(c0.w); v[7] = bf_hi(c0.w);
        ss = 0.f;
#pragma unroll
        for (int j = 0; j < 8; ++j) ss += v[j] * v[j];
        ss = wave_sum(ss);
        rstd = rsqrtf(ss * (1.0f / CW) + NORM_EPS);
        { const f32x4 g0 = *(const f32x4*)(g_c + 8 * lane), g1 = *(const f32x4*)(g_c + 8 * lane + 4);
          u32x4 w; w.x = pk_bf16(v[0] * rstd * g0[0], v[1] * rstd * g0[1]); w.y = pk_bf16(v[2] * rstd * g0[2], v[3] * rstd * g0[3]); w.z = pk_bf16(v[4] * rstd * g1[0], v[5] * rstd * g1[1]); w.w = pk_bf16(v[6] * rstd * g1[2], v[7] * rstd * g1[3]);
          *(u32x4*)(MIX + (size_t)t * DM + AW + 8 * lane) = w; }
    }
}

__device__ __forceinline__ void ins8(float (&tv)[8], int (&ti)[8], float cv, int ci) {
#pragma unroll
    for (int p = 0; p < 8; ++p) { const bool gt = cv > tv[p]; const float ov = tv[p]; const int oi = ti[p]; tv[p] = gt ? cv : ov; ti[p] = gt ? ci : oi; cv = gt ? ov : cv; ci = gt ? oi : ci; }
}
__device__ __forceinline__ void route_phase(const Args& a, LAS unsigned char* lds, int gcnt_off) {
    const int tid = threadIdx.x, lane = tid & 63, j4 = tid & 3;
    unsigned char* ws = a.ws;
    const float* logits = (const float*)(ws + WS_ZB); const float* b_r = a.in[18];
    int* IDX = (int*)(ws + WS_IDX); float* RW = (float*)(ws + WS_RW); int* POS = (int*)(ws + WS_POS);
    unsigned* gcnt = (unsigned*)(ws + WS_CTL) + gcnt_off;
    LAS float* bias = (LAS float*)lds;
    LAS int* hist = (LAS int*)(lds + 1024);
    LAS int* base = (LAS int*)(lds + 2048);
    for (int i = tid; i < NEXP; i += 512) bias[i] = b_r[i];
    for (int blk = blockIdx.x; blk < NT / 128; blk += gridDim.x) {
        for (int i = tid; i < NEXP; i += 512) hist[i] = 0;
        __syncthreads();
        const int t = blk * 128 + (tid >> 2);
        float sb[64];
        { const f32x4* lp = (const f32x4*)(logits + (size_t)t * NEXP + 64 * j4);
#pragma unroll
          for (int c = 0; c < 16; ++c) { const f32x4 x = lp[c];
#pragma unroll
              for (int j = 0; j < 4; ++j) sb[4 * c + j] = sigmoid_fast(x[j]) + bias[64 * j4 + 4 * c + j]; } }
        float gs2[2];
#pragma unroll
        for (int g = 0; g < 2; ++g) { float m1 = -1e30f, m2 = -1e30f;
#pragma unroll
            for (int i = 0; i < 32; ++i) { const float v = sb[32 * g + i]; const float n1 = fmaxf(m1, v); m2 = fmaxf(m2, fminf(m1, v)); m1 = n1; }
            gs2[g] = m1 + m2; }
        float gs[8];
#pragma unroll
        for (int g = 0; g < 8; ++g) gs[g] = __shfl((g & 1) ? gs2[1] : gs2[0], (lane & ~3) | (g >> 1));
        bool sel[2];
#pragma unroll
        for (int g2 = 0; g2 < 2; ++g2) { const int g = 2 * j4 + g2; const float me = (g2 == 0) ? gs2[0] : gs2[1]; int rank = 0;
#pragma unroll
            for (int o = 0; o < 8; ++o) rank += (gs[o] > me || (gs[o] == me && o < g)) ? 1 : 0;
            sel[g2] = rank < 4; }
        unsigned tk[8];
#pragma unroll
        for (int p = 0; p < 8; ++p) tk[p] = 0u;
#pragma unroll
        for (int i = 0; i < 64; ++i) { unsigned u = __float_as_uint(sb[i]); u ^= (unsigned)((int)u >> 31) | 0x80000000u;
            unsigned key = sel[i >> 5] ? ((u & 0xFFFFFF00u) | (unsigned)(255 - (64 * j4 + i))) : 0u;
#pragma unroll
            for (int p = 0; p < 8; ++p) { const unsigned hi = tk[p] > key ? tk[p] : key; key = tk[p] > key ? key : tk[p]; tk[p] = hi; } }
        unsigned mk[8];
#pragma unroll
        for (int p = 0; p < 8; ++p) mk[p] = tk[p];
#pragma unroll
        for (int step = 1; step <= 2; step <<= 1) {
            unsigned ok[8];
#pragma unroll
            for (int p = 0; p < 8; ++p) ok[p] = (unsigned)__shfl_xor((int)mk[p], step);
#pragma unroll
            for (int p = 0; p < 8; ++p) { unsigned key = ok[p];
#pragma unroll
                for (int r = 0; r < 8; ++r) { const unsigned hi = mk[r] > key ? mk[r] : key; key = mk[r] > key ? key : mk[r]; mk[r] = hi; } } }
        int myk[2], mye[2], myr[2]; float myw[2];
#pragma unroll
        for (int p = 0; p < 8; ++p) { if ((p >> 1) == j4) { myk[p & 1] = p; mye[p & 1] = 255 - (int)(mk[p] & 255u); } }
        float wsum = 0.f;
#pragma unroll
        for (int q = 0; q < 2; ++q) { myw[q] = sigmoid_fast(logits[(size_t)t * NEXP + mye[q]]); wsum += myw[q]; }
        wsum += __shfl_xor(wsum, 1); wsum += __shfl_xor(wsum, 2);
        const float wscale = 2.5f / wsum;
#pragma unroll
        for (int q = 0; q < 2; ++q) myw[q] *= wscale;
#pragma unroll
        for (int q = 0; q < 2; ++q) myr[q] = atomicAdd((int*)&hist[mye[q]], 1);
        __syncthreads();
        if (tid < NEXP) { const int h = hist[tid]; base[tid] = h ? (int)atomicAdd(&gcnt[tid * 32], (unsigned)h) : 0; }
        __syncthreads();
#pragma unroll
        for (int q = 0; q < 2; ++q) { const size_t o = (size_t)t * 8 + myk[q]; IDX[o] = mye[q]; RW[o] = myw[q]; POS[o] = base[mye[q]] + myr[q]; }
        __syncthreads();
    }
}

__device__ __forceinline__ void dispatch_phase(const Args& a, LAS unsigned char* lds) {
    const int tid = threadIdx.x;
    unsigned char* ws = a.ws;
    unsigned* ctl = (unsigned*)(ws + WS_CTL);
    const int* IDX = (const int*)(ws + WS_IDX); int* POS = (int*)(ws + WS_POS);
    int* AIDS = (int*)(ws + WS_AIDS); int* TEXP = (int*)(ws + WS_TEXP);
    LAS int* cnt = (LAS int*)lds; LAS int* pst = (LAS int*)(lds + 1024);
    for (int i = tid; i < NEXP; i += 512) cnt[i] = (int)ctl[CW_GCNT + i * 32];
    __syncthreads();
    { LAS int* wtot = pst + 260; const int lane = tid & 63, wv = tid >> 6;
      int own = 0, inc = 0;
      if (tid < NEXP) { own = (cnt[tid] + 255) & ~255; inc = own;
#pragma unroll
          for (int d = 1; d < 64; d <<= 1) { const int n = __shfl_up(inc, d); inc += (lane >= d) ? n : 0; }
          if (lane == 63) wtot[wv] = inc; }
      __syncthreads();
      if (tid < NEXP) { int off = 0;
#pragma unroll
          for (int w = 0; w < 4; ++w) off += (w < wv) ? wtot[w] : 0;
          pst[tid] = off + inc - own; if (tid == NEXP - 1) pst[NEXP] = off + inc; } }
    __syncthreads();
    for (int id = blockIdx.x * 512 + tid; id < NT * 8; id += gridDim.x * 512) { const int e = IDX[id]; const int slot = pst[e] + POS[id]; AIDS[slot] = id; POS[id] = slot; }
    for (int e = blockIdx.x; e < NEXP; e += gridDim.x) {
        const int c = cnt[e], pc = (c + 255) & ~255, s0 = pst[e];
        for (int i = c + tid; i < pc; i += 512) AIDS[s0 + i] = -1;
        for (int i = tid; i < pc / 256; i += 512) TEXP[s0 / 256 + i] = e;
    }
    if (blockIdx.x == 0 && tid == 0) ctl[CW_NTILES] = (unsigned)(pst[NEXP] / 256);
}

__device__ __forceinline__ void final_phase(const Args& a, float* dst) {
    const int lane = threadIdx.x & 63, wave = __builtin_amdgcn_readfirstlane(threadIdx.x >> 6);
    const unsigned char* Y = a.ws + WS_YBUF; const bf16_t* X1 = (const bf16_t*)(a.ws + WS_X1B);
    const float* RW = (const float*)(a.ws + WS_RW);
    const float* gate = (const float*)(a.ws + WS_ADA) + 5120; const float* gf = a.in[25];
    f32x4 gfv[4];
#pragma unroll
    for (int q = 0; q < 4; ++q) gfv[q] = *(const f32x4*)(gf + 16 * lane + 4 * q);
    for (int t = (blockIdx.x * 8 + wave) * 2; t < NT; t += gridDim.x * 16) {
        const int b = t >> 13;
        f32x4 rwv[2][2]; u32x4 yw[2][9]; u32x4 xw[2][2];
#pragma unroll
        for (int r = 0; r < 2; ++r) { rwv[r][0] = *(const f32x4*)(RW + (size_t)(t + r) * 8); rwv[r][1] = *(const f32x4*)(RW + (size_t)(t + r) * 8 + 4);
#pragma unroll
            for (int k = 0; k < 9; ++k) yw[r][k] = *(const u32x4*)(Y + ((size_t)(t + r) * 9 + k) * DM + 16 * lane);
            xw[r][0] = *(const u32x4*)(X1 + (size_t)(t + r) * DM + 16 * lane); xw[r][1] = *(const u32x4*)(X1 + (size_t)(t + r) * DM + 16 * lane + 8); }
        f32x4 gt[4];
#pragma unroll
        for (int q = 0; q < 4; ++q) gt[q] = *(const f32x4*)(gate + (size_t)b * 6144 + 16 * lane + 4 * q);
#pragma unroll
        for (int r = 0; r < 2; ++r) {
            float acc[16];
#pragma unroll
            for (int i = 0; i < 16; ++i) acc[i] = 0.f;
#pragma unroll
            for (int k = 0; k < 9; ++k) { const float wk = (k < 8 ? rwv[r][(k < 8 ? k : 0) >> 2][(k < 8 ? k : 0) & 3] : 1.0f) * 0.0625f;
#pragma unroll
                for (int q = 0; q < 4; ++q) { const int w = (int)yw[r][k][q];
                    const f32x2 lo = __builtin_amdgcn_cvt_pk_f32_fp8(w, false), hi = __builtin_amdgcn_cvt_pk_f32_fp8(w, true);
                    acc[4 * q + 0] += wk * lo[0]; acc[4 * q + 1] += wk * lo[1]; acc[4 * q + 2] += wk * hi[0]; acc[4 * q + 3] += wk * hi[1]; } }
            const u32x4 xw0 = xw[r][0], xw1 = xw[r][1];
            float xv[16];
            xv[0] = bf_lo(xw0.x); xv[1] = bf_hi(xw0.x); xv[2] = bf_lo(xw0.y); xv[3] = bf_hi(xw0.y); xv[4] = bf_lo(xw0.z); xv[5] = bf_hi(xw0.z); xv[6] = bf_lo(xw0.w); xv[7] = bf_hi(xw0.w);
            xv[8] = bf_lo(xw1.x); xv[9] = bf_hi(xw1.x); xv[10] = bf_lo(xw1.y); xv[11] = bf_hi(xw1.y); xv[12] = bf_lo(xw1.z); xv[13] = bf_hi(xw1.z); xv[14] = bf_lo(xw1.w); xv[15] = bf_hi(xw1.w);
            float v[16]; float ss = 0.f;
#pragma unroll
            for (int q = 0; q < 4; ++q)
#pragma unroll
                for (int j = 0; j < 4; ++j) { const float y = xv[4 * q + j] + gt[q][j] * acc[4 * q + j]; v[4 * q + j] = y; ss += y * y; }
            ss = wave_sum(ss);
            const float rstd = rsqrtf(ss * (1.0f / DM) + NORM_EPS);
#pragma unroll
            for (int q = 0; q < 4; ++q) { const f32x4 gv = gfv[q];
                f32x4 o; o[0] = v[4 * q + 0] * rstd * gv[0]; o[1] = v[4 * q + 1] * rstd * gv[1]; o[2] = v[4 * q + 2] * rstd * gv[2]; o[3] = v[4 * q + 3] * rstd * gv[3];
                *(f32x4*)(dst + (size_t)(t + r) * DM + 16 * lane + 4 * q) = o; }
        }
    }
}

extern __shared__ __attribute__((aligned(16))) unsigned char dyn_lds[];

__global__ void __launch_bounds__(512, 2) __attribute__((amdgpu_waves_per_eu(2, 2))) hymba_fwd(Args a) {
    LAS unsigned char* lds = (LAS unsigned char*)dyn_lds;
    const int tid = threadIdx.x, G = gridDim.x, bx = blockIdx.x;
    unsigned char* ws = a.ws;
    unsigned* ctl = (unsigned*)(ws + WS_CTL);
    if (tid < 4) ((LAS unsigned*)(lds + LDS_BAR_OFF))[tid] = 0u;
    __syncthreads();
    XcdBarrier bar; bar.bar = ctl + CW_BAR; bar.x = 0; bar.st = (volatile LAS unsigned*)(lds + LDS_BAR_OFF);
    const bool one_launch = (a.ph_hi - a.ph_lo) > 1;
    if (one_launch) bar = xcd_barrier_post(ctl + CW_BAR, (volatile LAS unsigned*)(lds + LDS_BAR_OFF));
#define IN(k) (a.ph_lo <= (k) && (k) < a.ph_hi)
#define SEAM(k) do { if (IN(k) && IN((k) + 1)) xcd_barrier(bar); } while (0)
    const float* ada = (const float*)(ws + WS_ADA);
    const bool has_conv = (G == 256);
    const int Gc = has_conv ? 183 : G, cx = bx, nconv = G - Gc, kconv = bx - Gc; const bool is_conv = has_conv && bx >= Gc;
    constexpr int JSPLIT = 3750;
    const bool has_conv3 = has_conv;
    const int G3 = has_conv3 ? 171 : G, c3 = bx, nconv3 = G - G3, kconv3 = bx - G3; const bool is_conv3 = has_conv3 && bx >= G3;

#define RUN(k, ...) do { if (IN((k) % 100)) { __VA_ARGS__ } if (PROBE_PH == (k)) { if (IN((k) % 100)) { __VA_ARGS__ } if (IN((k) % 100)) { __VA_ARGS__ } } } while (0)
    RUN(0, p0_prologue(a, lds); );
    SEAM(0);
    RUN(1, normmod_phase(a.in[0], a.in[3], ada + 0, ada + 1024, (bf16_t*)(ws + WS_HB)); );
    SEAM(1);
    RUN(2,
        if (is_conv) convert_f8_jobs(a, lds, 0, JSPLIT, kconv, nconv);
        else {
        GemmDense g{(const char*)(ws + WS_HB), (const char*)(ws + WS_WIN), NT, NPROJ, DM * 2, DM * 2, Gc, cx};
        EpiInProj E{(bf16_t*)(ws + WS_QKV), (bf16_t*)(ws + WS_AB), (const float*)(ws + WS_ROPE), lds + LDS_XCH_OFF};
        gemm_phase(lds, g, E);
        }
    );
    SEAM(2);
#define P3X(AM_) do { if (IN(3) && !is_conv3) { const bf16_t* Q = (const bf16_t*)(ws + WS_QKV); const bf16_t* Kb = Q + (size_t)NT * AW; const bf16_t* Vb = Kb + (size_t)NT * AW; \
        for (int rep_ = 0; rep_ < 2; ++rep_) for (int u = c3; u < NB * NHEAD * 3 * 32; u += G3) attn_unit<AM_>(u, lds, Q, Kb, Vb, (bf16_t*)(ws + WS_OB), (float*)(ws + WS_LSE)); } } while (0)
    if (PROBE_PH == 1003) P3X(1);
    if (PROBE_PH == 2003) P3X(2);
    if (PROBE_PH == 3003) P3X(3);
    if (PROBE_PH == 4003) P3X(0);
    RUN(3,
        const bf16_t* Q = (const bf16_t*)(ws + WS_QKV); const bf16_t* Kb = Q + (size_t)NT * AW; const bf16_t* Vb = Kb + (size_t)NT * AW;
        if (!has_conv3 && has_conv) { if (is_conv) convert_f8_jobs(a, lds, JSPLIT, JOBS_F8, kconv, nconv); else for (int u = cx; u < NB * NHEAD * 3 * 32; u += Gc) attn_unit(u, lds, Q, Kb, Vb, (bf16_t*)(ws + WS_OB), (float*)(ws + WS_LSE)); }
        else if (is_conv3) convert_f8_jobs(a, lds, JSPLIT, JOBS_F8, kconv3, nconv3);
        else for (int u = c3; u < NB * NHEAD * 3 * 32; u += G3) attn_unit(u, lds, Q, Kb, Vb, (bf16_t*)(ws + WS_OB), (float*)(ws + WS_LSE));
    );
    RUN(103,
        { float wv[CONVK];
          _Pragma("unroll") for (int j = 0; j < CONVK; ++j) wv[j] = a.in[7][j * CW + tid];
          const float bd = a.in[8][tid];
          __syncthreads();
          if (bx < NT / 32) conv_stage(bx, lds + 65536, (const bf16_t*)(ws + WS_AB));
          for (int u = bx; u < NT / 32; u += G) conv_unit(u, (u + G < NT / 32) ? u + G : -1, lds, (const bf16_t*)(ws + WS_AB), wv, bd, a.in[9], a.in[10], (bf16_t*)(ws + WS_ZB)); }
    );
    SEAM(3);
    RUN(4,
        GemmDense g{(const char*)(ws + WS_ZB), (const char*)(ws + WS_WPW2), NT, CW, CW * 2, CW * 2, G, bx};
        EpiPw2Norm E{a.in[12], a.in[14], (bf16_t*)(ws + WS_QKV), (float*)(ws + WS_RWS) + 262144, ctl + CW_PANEL2, lds + LDS_XCH_OFF};
        gemm_phase(lds, g, E);
        mix_phase((const bf16_t*)(ws + WS_OB), (const float*)(ws + WS_LSE), nullptr, a.in[13], a.in[14], (bf16_t*)(ws + WS_QKV));
    );
    SEAM(5);
    RUN(6,
        GemmDense g{(const char*)(ws + WS_QKV), (const char*)(ws + WS_WOUT), NT, DM, DM * 2, DM * 2, G, bx};
        EpiOutNorm E{a.in[0], (bf16_t*)(ws + WS_X1B), ada, a.in[16], (bf16_t*)(ws + WS_HB), (unsigned char*)(ws + WS_H2F8), (float*)(ws + WS_RWS), ctl + CW_PANEL, lds + LDS_XCH_OFF};
        gemm_phase(lds, g, E);
    );
    SEAM(6);
    RUN(8,
        GemmDense g{(const char*)(ws + WS_HB), (const char*)(ws + WS_WR), NT, NEXP, DM * 2, DM * 2, G, bx};
        EpiF32 E{(float*)(ws + WS_ZB), NEXP};
        gemm_phase(lds, g, E);
    );
    SEAM(8);
    if (PROBE_PH == 9) { route_phase(a, lds, CW_GCNT + 8); route_phase(a, lds, CW_GCNT + 16); }
    RUN(109, route_phase(a, lds, CW_GCNT); );
    SEAM(9);
    RUN(10, dispatch_phase(a, lds); );
    SEAM(10);
#define P11X(MODE_) do { if (IN(11)) { const int ntiles = (int)__hip_atomic_load(ctl + CW_NTILES, __ATOMIC_RELAXED, __HIP_MEMORY_SCOPE_AGENT); \
        GemmGU g{(const char*)(ws + WS_H2F8), (const char*)(ws + WS_WGU), (const int*)(ws + WS_AIDS), (const int*)(ws + WS_TEXP), ntiles, DM, G, bx, lds + LDS_XCH_OFF + 20480}; EpiGU E{(unsigned char*)(ws + WS_HBUF)}; \
        gemm_phase<MODE_>(lds, g, E); gemm_phase<MODE_>(lds, g, E); } } while (0)
    if (PROBE_PH == 1011) P11X(1);
    if (PROBE_PH == 2011) P11X(2);
    if (PROBE_PH == 3011) P11X(3);
#define P12X(MODE_) do { if (IN(12)) { const int ntiles = (int)__hip_atomic_load(ctl + CW_NTILES, __ATOMIC_RELAXED, __HIP_MEMORY_SCOPE_AGENT); \
        GemmDown g{(const char*)(ws + WS_HBUF), (const char*)(ws + WS_WDT), (const int*)(ws + WS_TEXP), ntiles, FE, G, bx}; EpiDown E{(unsigned char*)(ws + WS_YBUF), lds + LDS_XCH_OFF, (const int*)(ws + WS_AIDS)}; \
        gemm_phase<MODE_>(lds, g, E); gemm_phase<MODE_>(lds, g, E); } } while (0)
    RUN(11,
        const int ntiles = (int)__hip_atomic_load(ctl + CW_NTILES, __ATOMIC_RELAXED, __HIP_MEMORY_SCOPE_AGENT);
        GemmGU g{(const char*)(ws + WS_H2F8), (const char*)(ws + WS_WGU), (const int*)(ws + WS_AIDS), (const int*)(ws + WS_TEXP), ntiles, DM, G, bx, lds + LDS_XCH_OFF + 20480};
        EpiGU E{(unsigned char*)(ws + WS_HBUF)};
        gemm_phase(lds, g, E);
    );
    SEAM(11);
    if (PROBE_PH == 1012) P12X(1);
    if (PROBE_PH == 2012) P12X(2);
    if (PROBE_PH == 3012) P12X(3);
    RUN(12,
        const int ntiles = (int)__hip_atomic_load(ctl + CW_NTILES, __ATOMIC_RELAXED, __HIP_MEMORY_SCOPE_AGENT);
        GemmDown g{(const char*)(ws + WS_HBUF), (const char*)(ws + WS_WDT), (const int*)(ws + WS_TEXP), ntiles, FE, G, bx};
        EpiDown E{(unsigned char*)(ws + WS_YBUF), lds + LDS_XCH_OFF, (const int*)(ws + WS_AIDS)};
        gemm_phase(lds, g, E);
    );
    SEAM(12);
    RUN(13, final_phase(a, a.out); );
#undef RUN
#undef IN
#undef SEAM
}

extern "C" void kernel_launch(void* const* d_in, const int* in_sizes, int n_in, void* d_out, int out_size, void* d_ws, size_t ws_size, hipStream_t stream) {
    static int grid = 0;
    if (grid == 0) {
        if (n_in != 26 || out_size != NT * DM || ws_size < WS_END) { fprintf(stderr, "kernel_launch: unexpected problem (n_in %d out %d ws %zu need %zu)\n", n_in, out_size, ws_size, (size_t)WS_END); grid = -1; return; }
        int dev = 0, cus = 0, per_cu = 0;
        if (hipGetDevice(&dev) != hipSuccess || hipDeviceGetAttribute(&cus, hipDeviceAttributeMultiprocessorCount, dev) != hipSuccess) { grid = -1; return; }
        if (hipFuncSetAttribute((const void*)hymba_fwd, hipFuncAttributeMaxDynamicSharedMemorySize, LDS_BYTES) != hipSuccess) { fprintf(stderr, "kernel_launch: hipFuncSetAttribute failed\n"); grid = -1; return; }
        if (hipOccupancyMaxActiveBlocksPerMultiprocessor(&per_cu, (const void*)hymba_fwd, 512, LDS_BYTES) != hipSuccess || per_cu < 1) fprintf(stderr, "kernel_launch: occupancy query says %d\n", per_cu);
        (void)hipGetLastError();
        grid = cus;
    }
    if (grid < 0) return;
    (void)hipMemsetAsync((char*)d_ws + WS_CTL, 0, CTL_BYTES, stream);
    Args a{};
    for (int i = 0; i < 26; ++i) a.in[i] = (const float*)d_in[i];
    a.out = (float*)d_out; a.ws = (unsigned char*)d_ws;
#if MK_N_LAUNCHES == 1
    a.ph_lo = 0; a.ph_hi = NPHASE;
    hipLaunchKernelGGL(hymba_fwd, dim3(grid), dim3(512), LDS_BYTES, stream, a);
#else
    for (int p = 0; p < NPHASE; ++p) { a.ph_lo = p; a.ph_hi = p + 1; hipLaunchKernelGGL(hymba_fwd, dim3(grid), dim3(512), LDS_BYTES, stream, a); }
#endif
}
```
